# Optimizing an MI355X kernel written in HIP

```python
import jax, jax.numpy as jnp
from jax import lax
import numpy as np

D_MODEL = 2048
BATCH = 1
SEQ = 8192
DEPTH = 2

RW_HEAD = 64
RW_HEADS = 16
RW_DIM = RW_HEADS * RW_HEAD
W_LORA = 96
A_LORA = 96
V_LORA = 64
G_LORA = 256
GN_EPS = 64e-5
MLA_HEADS = 8
Q_LORA = 512
KV_LORA = 512
QK_NOPE = 128
QK_ROPE = 64
V_HEAD = 128
MLA_DIM = MLA_HEADS * V_HEAD
ROPE_THETA = 10000.0
Q_BLOCK = 128
CHUNK = 128
SG_GROUPS = 8
SG_GROUP_DIM = 128
SG_DIM = SG_GROUPS * SG_GROUP_DIM
D_FF = 5632
CONV_W = 3
RMS_EPS = 1e-6
LN_EPS = 1e-5
N_RW = 3 * RW_DIM + W_LORA + A_LORA + G_LORA
N_DQ = Q_LORA
N_DKV = KV_LORA + QK_ROPE
N_SG = 2 * SG_DIM
N_GATE = 3 * D_MODEL
N_IN = N_RW + N_DQ + N_DKV + N_SG + N_GATE

kernel_name = "hybrid_rwkv7_mla_gmlp_gated_trunk"


def _split(x, sizes):
    idx = [int(i) for i in np.cumsum(sizes)[:-1]]
    return jnp.split(x, idx, axis=-1)


def _rmsnorm(x, g):
    xf = x.astype(jnp.float32)
    y = xf * lax.rsqrt(jnp.mean(xf * xf, axis=-1, keepdims=True) + RMS_EPS)
    return (y * g.astype(jnp.float32)).astype(x.dtype)


def _layernorm(x, g, b):
    xf = x.astype(jnp.float32)
    mu = jnp.mean(xf, axis=-1, keepdims=True)
    var = jnp.mean(jnp.square(xf - mu), axis=-1, keepdims=True)
    y = (xf - mu) * lax.rsqrt(var + LN_EPS) * g.astype(jnp.float32) + b.astype(jnp.float32)
    return y.astype(x.dtype)


def _rope_tables(positions):
    inv = ROPE_THETA ** (-jnp.arange(0, QK_ROPE, 2, dtype=jnp.float32) / QK_ROPE)
    ang = positions.astype(jnp.float32)[..., None] * inv
    return jnp.cos(ang), jnp.sin(ang)


def _rope(x, cos, sin):
    half = x.shape[-1] // 2
    x1, x2 = x[..., :half], x[..., half:]
    cos = cos.astype(x.dtype)
    sin = sin.astype(x.dtype)
    return jnp.concatenate([x1 * cos - x2 * sin, x1 * sin + x2 * cos], axis=-1)


def _rwkv7_scan(r, w, k, v, a, b):
    B_, T, H, N = r.shape

    def step(S, inp):
        r_t, w_t, k_t, v_t, a_t, b_t = inp
        sa = jnp.einsum('bhvk,bhk->bhv', S, a_t)
        S = (S * w_t[:, :, None, :] + sa[..., None] * b_t[:, :, None, :]
             + v_t[..., None] * k_t[:, :, None, :])
        return S, jnp.einsum('bhvk,bhk->bhv', S, r_t)

    S0 = jnp.zeros((B_, H, N, N), jnp.float32)
    xs = tuple(jnp.moveaxis(t, 1, 0) for t in (r, w, k, v, a, b))
    _, ys = lax.scan(step, S0, xs)
    return jnp.moveaxis(ys, 0, 1)


def _rwkv7_time_mix(p_rw, mu, w0, w2, a0, a2, g2, k_k, k_a, r_k, lnx_w, lnx_b, v_first, v_res):
    B_, T, _ = p_rw.shape
    f32 = jnp.float32
    prev = jnp.pad(p_rw, ((0, 0), (1, 0), (0, 0)))[:, :-1]
    p = p_rw + (prev - p_rw) * mu
    r, k, v, xw, xa, xg = _split(p, [RW_DIM, RW_DIM, RW_DIM, W_LORA, A_LORA, G_LORA])
    if v_res is not None:
        v0, v1, v2 = v_res
        v = v + (v_first - v) * jax.nn.sigmoid(v0 + (v @ v1) @ v2)
    w_log = -jax.nn.softplus(-(w0 + jnp.tanh(xw) @ w2).astype(f32)) - 0.5
    decay = jnp.exp(-jnp.exp(w_log))
    a = jax.nn.sigmoid((a0 + xa @ a2).astype(f32))
    g = jax.nn.sigmoid(xg) @ g2

    def heads(t):
        return t.astype(f32).reshape(B_, T, RW_HEADS, RW_HEAD)

    kk = heads(k * k_k)
    kk = kk / jnp.maximum(jnp.sqrt(jnp.sum(kk * kk, axis=-1, keepdims=True)), 1e-12)
    kh = heads(k.astype(f32) * (1.0 + (a - 1.0) * k_a.astype(f32)))
    rh, vh, ah = heads(r), heads(v), heads(a)
    y = _rwkv7_scan(rh, heads(decay), kh, vh, -kk, kk * ah)
    mean = jnp.mean(y, axis=-1, keepdims=True)
    var = jnp.mean(jnp.square(y - mean), axis=-1, keepdims=True)
    y = ((y - mean) * lax.rsqrt(var + GN_EPS)).reshape(B_, T, RW_DIM)
    y = y * lnx_w.astype(f32) + lnx_b.astype(f32)
    bonus = (jnp.sum(rh * kh * r_k.astype(f32), axis=-1, keepdims=True) * vh).reshape(B_, T, RW_DIM)
    out = ((y + bonus) * g.astype(f32)).astype(p_rw.dtype)
    return out, v


def _mla(p_dq, p_dkv, cos, sin, q_norm, kv_norm, w_uq, w_ukv, qn_nope, qn_rope, kn_nope, kn_rope):
    B_, T, _ = p_dq.shape
    q = (_rmsnorm(p_dq, q_norm) @ w_uq).reshape(B_, T, MLA_HEADS, QK_NOPE + QK_ROPE)
    q_nope, q_rope = q[..., :QK_NOPE], q[..., QK_NOPE:]
    c_kv, k_rope = p_dkv[..., :KV_LORA], p_dkv[..., KV_LORA:]
    kv = (_rmsnorm(c_kv, kv_norm) @ w_ukv).reshape(B_, T, MLA_HEADS, QK_NOPE + V_HEAD)
    k_nope, v = kv[..., :QK_NOPE], kv[..., QK_NOPE:]
    q_nope = _rmsnorm(q_nope, qn_nope)
    k_nope = _rmsnorm(k_nope, kn_nope)
    q_rope = _rope(_rmsnorm(q_rope, qn_rope), cos[:, :, None, :], sin[:, :, None, :])
    k_rope = _rope(_rmsnorm(k_rope, kn_rope), cos, sin)
    scale = (QK_NOPE + QK_ROPE) ** -0.5
    k_idx = jnp.arange(T)

    def block(i):
        qs = i * Q_BLOCK
        qn = lax.dynamic_slice_in_dim(q_nope, qs, Q_BLOCK, axis=1)
        qr = lax.dynamic_slice_in_dim(q_rope, qs, Q_BLOCK, axis=1)
        s = (jnp.einsum('bqhd,bkhd->bhqk', qn, k_nope)
             + jnp.einsum('bqhd,bkd->bhqk', qr, k_rope)).astype(jnp.float32) * scale
        q_idx = qs + jnp.arange(Q_BLOCK)
        s = jnp.where(k_idx[None, :] <= q_idx[:, None], s, -jnp.inf)
        pr = jax.nn.softmax(s, axis=-1).astype(v.dtype)
        return jnp.einsum('bhqk,bkhd->bqhd', pr, v)

    o = lax.map(block, jnp.arange(T // Q_BLOCK))
    return jnp.moveaxis(o, 0, 1).reshape(B_, T, MLA_DIM)


def _spatial_gating(p_u, p_v, ln_w, ln_b, ws, bs):
    B_, T, _ = p_u.shape
    u = jax.nn.gelu(p_u)
    v = _layernorm(jax.nn.gelu(p_v), ln_w, ln_b)
    vc = v.reshape(B_, T // CHUNK, CHUNK, SG_GROUPS, SG_GROUP_DIM)
    mask = jnp.tril(jnp.ones((CHUNK, CHUNK), dtype=bool))
    w = jnp.where(mask[None], ws, jnp.zeros_like(ws))
    s = jnp.einsum('gts,bnsgc->bntgc', w, vc) + bs.T[None, None, :, :, None]
    return u * s.reshape(B_, T, SG_DIM)


def _conv_ffn(h, w_up, conv_w, conv_b, w_down):
    up = h @ w_up
    T = up.shape[1]
    padded = jnp.pad(up, ((0, 0), (CONV_W - 1, 0), (0, 0)))
    conv = conv_b + conv_w[0] * padded[:, 0:T]
    for j in range(1, CONV_W):
        conv = conv + conv_w[j] * padded[:, j:j + T]
    gate, val = jnp.split(conv, 2, axis=-1)
    return (jax.nn.silu(gate) * val) @ w_down


def setup_inputs(seed: int = 0) -> dict:
    key = jax.random.key(seed)
    ks = iter(jax.random.split(key, 64))
    f32 = jnp.float32
    D, L, Lv = D_MODEL, DEPTH, DEPTH - 1

    def nrm(shape, scale):
        return jax.random.normal(next(ks), shape, f32) * scale

    def gain(shape):
        return 1.0 + nrm(shape, 0.05)

    return {
        "x": nrm((BATCH, SEQ, D), 1.0),
        "c": nrm((BATCH, D), 1.0),
        "positions": (jnp.arange(SEQ, dtype=jnp.int32)[None, :]
                      + jax.random.randint(next(ks), (BATCH, 1), 0, SEQ, dtype=jnp.int32)),
        "ada_w": nrm((L, D, 6 * D), 0.5 * D ** -0.5),
        "ada_b": nrm((L, 6 * D), 0.01),
        "norm_mix_g": gain((L, D)),
        "norm_ffn_g": gain((L, D)),
        "w_in": nrm((L, D, N_IN), D ** -0.5),
        "rw_mu": jax.random.uniform(next(ks), (L, N_RW), f32),
        "rw_w0": jax.random.uniform(next(ks), (L, RW_DIM), f32, -5.0, -0.5),
        "rw_w2": nrm((L, W_LORA, RW_DIM), W_LORA ** -0.5),
        "rw_a0": nrm((L, RW_DIM), 0.1),
        "rw_a2": nrm((L, A_LORA, RW_DIM), A_LORA ** -0.5),
        "rw_g2": nrm((L, G_LORA, RW_DIM), G_LORA ** -0.5),
        "rw_kk": 0.85 + nrm((L, RW_DIM), 0.05),
        "rw_ka": gain((L, RW_DIM)),
        "rw_rk": nrm((L, RW_HEADS, RW_HEAD), 0.1),
        "rw_lnx_w": gain((L, RW_DIM)),
        "rw_lnx_b": nrm((L, RW_DIM), 0.01),
        "rw_v0": nrm((Lv, RW_DIM), 0.1),
        "rw_v1": nrm((Lv, RW_DIM, V_LORA), RW_DIM ** -0.5),
        "rw_v2": nrm((Lv, V_LORA, RW_DIM), V_LORA ** -0.5),
        "mla_q_norm": gain((L, Q_LORA)),
        "mla_kv_norm": gain((L, KV_LORA)),
        "mla_w_uq": nrm((L, Q_LORA, MLA_HEADS * (QK_NOPE + QK_ROPE)), Q_LORA ** -0.5),
        "mla_w_ukv": nrm((L, KV_LORA, MLA_HEADS * (QK_NOPE + V_HEAD)), KV_LORA ** -0.5),
        "mla_qn_nope": gain((L, QK_NOPE)),
        "mla_qn_rope": gain((L, QK_ROPE)),
        "mla_kn_nope": gain((L, QK_NOPE)),
        "mla_kn_rope": gain((L, QK_ROPE)),
        "sg_ln_w": gain((L, SG_DIM)),
        "sg_ln_b": nrm((L, SG_DIM), 0.01),
        "sg_ws": nrm((L, SG_GROUPS, CHUNK, CHUNK), CHUNK ** -0.5),
        "sg_b": 1.0 + nrm((L, SG_GROUPS, CHUNK), 0.1),
        "w_br_a": nrm((L, RW_DIM, D), RW_DIM ** -0.5),
        "w_br_b": nrm((L, MLA_DIM, D), MLA_DIM ** -0.5),
        "w_br_c": nrm((L, SG_DIM, D), SG_DIM ** -0.5),
        "w_out": nrm((L, D, D), D ** -0.5),
        "ffn_up": nrm((L, D, 2 * D_FF), D ** -0.5),
        "ffn_conv": nrm((L, CONV_W, 2 * D_FF), CONV_W ** -0.5),
        "ffn_conv_b": nrm((L, 2 * D_FF), 0.01),
        "ffn_down": nrm((L, D_FF, D), D_FF ** -0.5),
    }


def reference(x, c, positions, ada_w, ada_b, norm_mix_g, norm_ffn_g, w_in,
              rw_mu, rw_w0, rw_w2, rw_a0, rw_a2, rw_g2, rw_kk, rw_ka, rw_rk, rw_lnx_w, rw_lnx_b,
              rw_v0, rw_v1, rw_v2,
              mla_q_norm, mla_kv_norm, mla_w_uq, mla_w_ukv, mla_qn_nope, mla_qn_rope,
              mla_kn_nope, mla_kn_rope,
              sg_ln_w, sg_ln_b, sg_ws, sg_b,
              w_br_a, w_br_b, w_br_c, w_out,
              ffn_up, ffn_conv, ffn_conv_b, ffn_down):
    B_, T, D = x.shape
    cos, sin = _rope_tables(positions)
    v_first = None
    for l in range(DEPTH):
        mod = jax.nn.silu(c) @ ada_w[l] + ada_b[l]
        sh1, sc1, gt1, sh2, sc2, gt2 = jnp.split(mod[:, None, :], 6, axis=-1)

        h = _rmsnorm(x, norm_mix_g[l]) * (1.0 + sc1) + sh1
        proj = h @ w_in[l]
        p_rw, p_dq, p_dkv, p_u, p_v, p_gate = _split(
            proj, [N_RW, N_DQ, N_DKV, SG_DIM, SG_DIM, N_GATE])
        v_res = None if l == 0 else (rw_v0[l - 1], rw_v1[l - 1], rw_v2[l - 1])
        y_a, v_l = _rwkv7_time_mix(p_rw, rw_mu[l], rw_w0[l], rw_w2[l], rw_a0[l], rw_a2[l],
                                   rw_g2[l], rw_kk[l], rw_ka[l], rw_rk[l], rw_lnx_w[l],
                                   rw_lnx_b[l], v_first, v_res)
        if l == 0:
            v_first = v_l
        y_b = _mla(p_dq, p_dkv, cos, sin, mla_q_norm[l], mla_kv_norm[l], mla_w_uq[l],
                   mla_w_ukv[l], mla_qn_nope[l], mla_qn_rope[l], mla_kn_nope[l], mla_kn_rope[l])
        y_c = _spatial_gating(p_u, p_v, sg_ln_w[l], sg_ln_b[l], sg_ws[l], sg_b[l])
        gates = jax.nn.sigmoid(p_gate.astype(jnp.float32)).astype(x.dtype).reshape(B_, T, 3, D)
        merged = (gates[:, :, 0] * (y_a @ w_br_a[l])
                  + gates[:, :, 1] * (y_b @ w_br_b[l])
                  + gates[:, :, 2] * (y_c @ w_br_c[l]))
        x = x + gt1 * (merged @ w_out[l])

        h = _rmsnorm(x, norm_ffn_g[l]) * (1.0 + sc2) + sh2
        x = x + gt2 * _conv_ffn(h, ffn_up[l], ffn_conv[l], ffn_conv_b[l], ffn_down[l])
    return x
```

```cpp
#include <hip/hip_runtime.h>
#include <hip/hip_cooperative_groups.h>
#include <cstdio>
namespace cg = cooperative_groups;

#ifndef EN_MISC
#define EN_MISC 1
#endif
#ifndef EN_INIT
#define EN_INIT 1
#endif
#ifndef EN_PREP
#define EN_PREP 1
#endif
#ifndef EN_SCAN
#define EN_SCAN 1
#endif
#ifndef EN_ATTN
#define EN_ATTN 1
#endif
#ifndef EN_SG
#define EN_SG 1
#endif
#ifndef EN_GEMM
#define EN_GEMM 1
#endif
#ifndef PROBE_MASK
#define PROBE_MASK 0
#endif
#ifndef PROBE_PART
#define PROBE_PART 0
#endif
#ifndef N_LAUNCH_MODE
#define N_LAUNCH_MODE 1
#endif

typedef unsigned short bf16_t;
typedef short bf16x8 __attribute__((ext_vector_type(8)));
typedef float f32x4 __attribute__((ext_vector_type(4)));
typedef float f32x2 __attribute__((ext_vector_type(2)));
typedef unsigned u32x4 __attribute__((ext_vector_type(4)));
typedef unsigned u32x2 __attribute__((ext_vector_type(2)));
#define DEVI __device__ __forceinline__

constexpr int T = 8192, D = 2048, NL = 2;
constexpr int NIN = 12800;
constexpr int PW = 6912;
constexpr int PC_DQ = 3584, PC_CKV = 4096, PC_KR = 4608, PC_U = 4864, PC_VS = 5888;
constexpr int NGATE = 6144;
constexpr int DFF = 5632;
constexpr int NSCAN = 64;

constexpr size_t al256(size_t x) { return (x + 255) & ~(size_t)255; }
constexpr size_t WS_MOD = 0;
constexpr size_t WS_BAR = al256(WS_MOD + (size_t)NL * 6 * D * 4);
constexpr size_t WS_COS = WS_BAR + 16384;
constexpr size_t WS_SIN = WS_COS + (size_t)T * 32 * 4;
constexpr size_t WS_X   = WS_SIN + (size_t)T * 32 * 4;
constexpr size_t WS_VF  = WS_X + (size_t)T * D * 4;
constexpr size_t WT_IN  = WS_VF + (size_t)T * 1024 * 4;
constexpr size_t WTIN_BYTES = (size_t)13056 * 2048 * 2;
constexpr size_t WT_UQ  = WT_IN + 2 * WTIN_BYTES;
constexpr size_t WT_UKV = WT_UQ + (size_t)1536 * 512 * 2;
constexpr size_t WT_LW  = WT_UKV + (size_t)2048 * 512 * 2;
constexpr size_t WT_LA  = WT_LW + (size_t)1024 * 256 * 2;
constexpr size_t WT_LG  = WT_LA + (size_t)1024 * 256 * 2;
constexpr size_t WT_V1  = WT_LG + (size_t)1024 * 256 * 2;
constexpr size_t WT_V2  = WT_V1 + (size_t)256 * 1024 * 2;
constexpr size_t WT_BR  = WT_V2 + (size_t)1024 * 256 * 2;
constexpr size_t WT_OUT = WT_BR + (size_t)3 * 2048 * 1024 * 2;
constexpr size_t WT_UP  = WT_OUT + (size_t)2048 * 2048 * 2;
constexpr size_t WT_DN  = WT_UP + (size_t)11264 * 2048 * 2;
constexpr size_t WT_SG  = WT_DN + (size_t)2048 * 5632 * 2;
constexpr size_t A_H    = WT_SG + (size_t)8 * 128 * 128 * 2;
constexpr size_t A_P    = A_H + (size_t)T * 2048 * 2;
constexpr size_t A_GATE = A_P;
constexpr size_t A_LW   = A_P + (size_t)T * PW * 2;
constexpr size_t A_LA   = A_LW + (size_t)T * 1024 * 4;
constexpr size_t A_VG   = A_LA + (size_t)T * 1024 * 4;
constexpr size_t A_MACC = A_LW;
constexpr size_t A_MERG = A_VG;
constexpr size_t A_LG   = A_VG + (size_t)T * 1024 * 4;
constexpr size_t A_VL   = A_LG + (size_t)T * 1024 * 2;
constexpr size_t A_QRAW = A_VL + (size_t)T * 256 * 2;
constexpr size_t A_KVRAW= A_QRAW + (size_t)T * 1536 * 2;
constexpr size_t A_AL   = A_KVRAW + (size_t)T * 2048 * 2;
constexpr size_t A_VB   = A_AL + (size_t)T * 768 * 2;
constexpr size_t A_YSC  = A_QRAW;
constexpr size_t A_Y3   = A_YSC + (size_t)T * 1024 * 4;
constexpr size_t A_QL   = A_VB + (size_t)T * 1024 * 2;
constexpr size_t A_CKV  = A_QL + (size_t)T * 512 * 2;
constexpr size_t A_KR   = A_CKV + (size_t)T * 512 * 2;
constexpr size_t A_U    = A_KR + (size_t)T * 64 * 2;
constexpr size_t A_VN   = A_U + (size_t)T * 1024 * 2;
constexpr size_t A_KK   = A_VN + (size_t)T * 1024 * 2;
constexpr size_t A_KH   = A_KK + (size_t)T * 1024 * 4;
constexpr size_t A_R    = A_KH + (size_t)T * 1024 * 2;
constexpr size_t A_Q    = A_R + (size_t)T * 1024 * 2;
constexpr size_t A_K    = A_Q + (size_t)8 * T * 192 * 2;
constexpr size_t A_VT   = A_K + (size_t)8 * T * 192 * 2;
constexpr size_t WS_END = A_VT + (size_t)8 * 128 * T * 2;
constexpr size_t A_UP   = A_P;
constexpr size_t A_ACT  = A_UP + (size_t)T * 11264 * 2;
static_assert(A_Y3 + (size_t)T * 3072 * 2 <= A_QL, "alias overflow");
static_assert(A_ACT + (size_t)T * DFF * 2 <= WS_END, "ffn alias overflow");
static_assert(WS_END < 858000000ull, "workspace too large");

constexpr int LDS_BYTES = 131072;

struct Params {
  const void* in[42];
  float* out;
  unsigned char* ws;
  int ph_lo, ph_hi;
};

DEVI int lbid() { int t = __builtin_amdgcn_workgroup_id_x(); asm volatile("" : "+s"(t)); return t; }
DEVI const void* uptr(const void* p) { unsigned long long v = (unsigned long long)p; unsigned lo = __builtin_amdgcn_readfirstlane((unsigned)v), hi = __builtin_amdgcn_readfirstlane((unsigned)(v >> 32)); return (const void*)(((unsigned long long)hi << 32) | lo); }
DEVI int ltid() { int t = __builtin_amdgcn_workitem_id_x(); asm volatile("" : "+v"(t)); return t; }
DEVI unsigned cvt_pk_bf16(float lo, float hi) { unsigned r; asm("v_cvt_pk_bf16_f32 %0, %1, %2" : "=v"(r) : "v"(lo), "v"(hi)); return r; }
DEVI float bf_lo(unsigned u) { return __uint_as_float(u << 16); }
DEVI float bf_hi(unsigned u) { return __uint_as_float(u & 0xffff0000u); }
DEVI float bf2f(bf16_t h) { return __uint_as_float(((unsigned)h) << 16); }
DEVI bf16_t f2bf(float f) { return (bf16_t)(cvt_pk_bf16(f, 0.f) & 0xffffu); }
DEVI float sigmoidf_(float x) { return 1.f / (1.f + __expf(-x)); }
DEVI float tanhf_(float x) { x = fminf(fmaxf(x, -15.f), 15.f); float t = __expf(2.f * x); return (t - 1.f) / (t + 1.f); }
DEVI float geluf_(float x) { return 0.5f * x * (1.f + tanhf_(0.7978845608028654f * (x + 0.044715f * x * x * x))); }
DEVI float wave_sum(float v) {
#pragma unroll
  for (int o = 32; o > 0; o >>= 1) v += __shfl_xor(v, o);
  return v;
}
DEVI float sum16(float v) {
#pragma unroll
  for (int o = 8; o > 0; o >>= 1) v += __shfl_xor(v, o);
  return v;
}
DEVI float dpp_allreduce16(float x) {
  x += __builtin_bit_cast(float, __builtin_amdgcn_update_dpp(0, __builtin_bit_cast(int, x), 0xB1, 0xF, 0xF, true));
  x += __builtin_bit_cast(float, __builtin_amdgcn_update_dpp(0, __builtin_bit_cast(int, x), 0x4E, 0xF, 0xF, true));
  x += __builtin_bit_cast(float, __builtin_amdgcn_update_dpp(0, __builtin_bit_cast(int, x), 0x141, 0xF, 0xF, true));
  x += __builtin_bit_cast(float, __builtin_amdgcn_update_dpp(0, __builtin_bit_cast(int, x), 0x140, 0xF, 0xF, true));
  return x;
}
DEVI float xrow_max(float x) {
  auto a = __builtin_amdgcn_permlane16_swap(__float_as_uint(x), __float_as_uint(x), false, false);
  float m1 = fmaxf(__uint_as_float(a[0]), __uint_as_float(a[1]));
  auto b = __builtin_amdgcn_permlane32_swap(__float_as_uint(m1), __float_as_uint(m1), false, false);
  return fmaxf(__uint_as_float(b[0]), __uint_as_float(b[1]));
}
DEVI float xrow_sum(float x) {
  auto a = __builtin_amdgcn_permlane16_swap(__float_as_uint(x), __float_as_uint(x), false, false);
  float m1 = __uint_as_float(a[0]) + __uint_as_float(a[1]);
  auto b = __builtin_amdgcn_permlane32_swap(__float_as_uint(m1), __float_as_uint(m1), false, false);
  return __uint_as_float(b[0]) + __uint_as_float(b[1]);
}
DEVI f32x4 ld_bf4(const bf16_t* p) { u32x2 u = *(const u32x2*)p; return (f32x4){bf_lo(u.x), bf_hi(u.x), bf_lo(u.y), bf_hi(u.y)}; }
DEVI void st_bf4(bf16_t* p, f32x4 v) { u32x2 u; u.x = cvt_pk_bf16(v[0], v[1]); u.y = cvt_pk_bf16(v[2], v[3]); *(u32x2*)p = u; }


#define XB_TMO      128
#define XB_XCNT(j)  (256  + 64 * (j))
#define XB_XSUB(j)  (1280 + 64 * (j))
#define XB_XGEN(j)  (2304 + 64 * (j))
#define XB_TOP      3328
#define XB_TOPGEN   3392
#define XCD_BAR_WORDS 3456
#define XB_SPIN_CAP (1u << 20)
#define LAS __attribute__((address_space(3)))
DEVI unsigned xb_ld(unsigned* p) { return __hip_atomic_load(p, __ATOMIC_RELAXED, __HIP_MEMORY_SCOPE_AGENT); }
DEVI unsigned xb_add(unsigned* p, unsigned v) { return __hip_atomic_fetch_add(p, v, __ATOMIC_RELAXED, __HIP_MEMORY_SCOPE_AGENT); }
DEVI unsigned xb_xcc_id() { return (unsigned)__builtin_amdgcn_s_getreg((3 << 11) | 20) & 0xFu; }
#define XB_SPIN(cond, bar) do { unsigned _sp = 0; while (cond) { __builtin_amdgcn_s_sleep(4); \
    if ((++_sp & 255u) == 0u) { if (xb_ld(&(bar)[XB_TMO])) break; if (_sp > XB_SPIN_CAP) { atomicAdd(&(bar)[XB_TMO], 1u); break; } } } } while (0)
struct XcdBarrier { unsigned* bar; unsigned x; volatile LAS unsigned* st; };
DEVI XcdBarrier xcd_barrier_post(unsigned* bar, volatile LAS unsigned* st) {
  XcdBarrier b; b.bar = bar; b.x = xb_xcc_id(); b.st = st;
  if (__builtin_amdgcn_workitem_id_x() == 0) (void)xb_add(&bar[XB_XCNT(b.x)], 1u);
  return b;
}
DEVI void xcd_barrier_complete(unsigned* bar, unsigned x, unsigned& nloc, unsigned& nx) {
  const unsigned G = gridDim.x;
  unsigned sum, cnt, mine, sp = 0u;
  for (;;) {
    sum = 0u; cnt = 0u; mine = 0u;
#pragma unroll
    for (unsigned j = 0; j < 16; ++j) { const unsigned c = xb_ld(&bar[XB_XCNT(j)]); sum += c; cnt += (c > 0u) ? 1u : 0u; mine = (j == x) ? c : mine; }
    if (sum == G) break;
    __builtin_amdgcn_s_sleep(1);
    if ((++sp & 255u) == 0u) { if (xb_ld(&bar[XB_TMO])) break; if (sp > XB_SPIN_CAP) { atomicAdd(&bar[XB_TMO], 1u); break; } }
  }
  nloc = mine > 0u ? mine : 1u; nx = cnt > 0u ? cnt : 1u;
}
DEVI void xcd_barrier(const XcdBarrier& b) {
  asm volatile("s_waitcnt vmcnt(0)" ::: "memory");
  __syncthreads();
  if (__builtin_amdgcn_workitem_id_x() == 0) {
    unsigned* bar = b.bar;
    __builtin_amdgcn_s_waitcnt(0);
    unsigned nloc = b.st[0], nx = b.st[1];
    if (nloc == 0u) { xcd_barrier_complete(bar, b.x, nloc, nx); b.st[0] = nloc; b.st[1] = nx; }
    const unsigned old = xb_add(&bar[XB_XSUB(b.x)], 1u);
    const unsigned gen = old / nloc;
    if (old + 1u == (gen + 1u) * nloc) {
      __builtin_amdgcn_fence(__ATOMIC_RELEASE, "agent");
      asm volatile("s_waitcnt vmcnt(0)" ::: "memory");
      const unsigned og = xb_add(&bar[XB_TOP], 1u);
      const unsigned tg = og / nx;
      if (og + 1u == (tg + 1u) * nx) xb_add(&bar[XB_TOPGEN], 1u);
      else XB_SPIN(xb_ld(&bar[XB_TOPGEN]) == tg, bar);
      __builtin_amdgcn_fence(__ATOMIC_ACQUIRE, "agent");
      xb_add(&bar[XB_XGEN(b.x)], 1u);
      asm volatile("s_waitcnt vmcnt(0)" ::: "memory");
    } else {
      XB_SPIN(xb_ld(&bar[XB_XGEN(b.x)]) == gen, bar);
      __builtin_amdgcn_fence(__ATOMIC_ACQUIRE, "agent");
      asm volatile("s_waitcnt vmcnt(0)" ::: "memory");
    }
  }
  __syncthreads();
}

constexpr int BM = 256, BK = 64, HALF = 128, HT = HALF * BK, WGM = 8;
struct GJob { const bf16_t* A; const bf16_t* Bt; void* out; const void* aux; const void* aux2; int lda, ldb, ldo, N, K, mode, keep; };

DEVI int lds_byte(int r, int c) { int st = (r >> 4) * 2 + (c >> 5), rr = r & 15, cc = c & 31, ob = rr * 64 + cc * 2; return st * 1024 + (ob ^ (((ob >> 9) & 1) << 5)); }
DEVI void stage_rc(int b, int& R, int& C) { int st = b >> 10, sb = b & 1023, swz = sb ^ (((sb >> 9) & 1) << 5); R = (st >> 1) * 16 + (swz >> 6); C = (st & 1) * 32 + ((swz & 63) >> 1); }

DEVI int perm32(int rho) { const int n = rho >> 4, i = rho & 15; return 8 * (i >> 2) + 4 * n + (i & 3); }
DEVI u32x4 pack8(f32x4 a, f32x4 b) { u32x4 o; o.x = cvt_pk_bf16(a[0], a[1]); o.y = cvt_pk_bf16(a[2], a[3]); o.z = cvt_pk_bf16(b[0], b[1]); o.w = cvt_pk_bf16(b[2], b[3]); return o; }
DEVI void gemm_epi(const GJob& jb, int row, int col, f32x4 v0, f32x4 v1) {
  const int mode = jb.mode;
  if (mode == 0) { *(u32x4*)((bf16_t*)jb.out + (size_t)row * jb.ldo + col) = pack8(v0, v1); }
  else if (mode == 1) { float* p = (float*)jb.out + (size_t)row * jb.ldo + col; *(f32x4*)p = v0; *(f32x4*)(p + 4) = v1; }
  else if (mode == 2) { f32x4 s0, s1; for (int i = 0; i < 4; ++i) { s0[i] = sigmoidf_(v0[i]); s1[i] = sigmoidf_(v1[i]); } *(u32x4*)((bf16_t*)jb.out + (size_t)row * jb.ldo + col) = pack8(s0, s1); }
  else if (mode == 7) {
    const u32x4 g = *(const u32x4*)((const bf16_t*)jb.aux + (size_t)row * NGATE + 2 * 2048 + col);
    const f32x4 g0 = {bf_lo(g.x), bf_hi(g.x), bf_lo(g.y), bf_hi(g.y)}, g1 = {bf_lo(g.z), bf_hi(g.z), bf_lo(g.w), bf_hi(g.w)};
    *(u32x4*)((bf16_t*)jb.out + (size_t)row * 2048 + col) = pack8(g0 * v0, g1 * v1);
  } else {
    const float* xp = (const float*)jb.aux + (size_t)row * jb.ldo + col; const float* gp = (const float*)jb.aux2 + col;
    float* op = (float*)jb.out + (size_t)row * jb.ldo + col;
    const f32x4 x0 = *(const f32x4*)xp, x1 = *(const f32x4*)(xp + 4), t0 = *(const f32x4*)gp, t1 = *(const f32x4*)(gp + 4);
    *(f32x4*)op = x0 + t0 * v0; *(f32x4*)(op + 4) = x1 + t1 * v1;
  }
}

DEVI void gemm_tile(const GJob& jb, int brow, int bcol, unsigned char* shm_) {
  LAS unsigned char* lds = (LAS unsigned char*)shm_;
  const int lda = jb.lda, ldb = jb.ldb, K = jb.K;
  const int tid = ltid(), wid = __builtin_amdgcn_readfirstlane(tid >> 6), lane = tid & 63, wr = wid >> 2, wc = wid & 3, fr = lane & 15, fq = lane >> 4;
  unsigned voffA[2], voffB[2];
#pragma unroll
  for (int i = 0; i < 2; ++i) { int R, C; stage_rc(tid * 16 + i * 8192, R, C); const int Rb = (R & ~31) + perm32(R & 31); voffA[i] = (unsigned)(R * lda + C) * 2u; voffB[i] = (unsigned)(Rb * ldb + C) * 2u; }
  const size_t hA = (size_t)HALF * lda * 2, hB = (size_t)HALF * ldb * 2;
  const unsigned ldsw = (unsigned)wid * 1024u;
  const int aoff = lds_byte(wr * 64 + fr, fq * 8), boff = lds_byte(wc * 32 + fr, fq * 8);
  constexpr int HTB = HT * 2;
#define SA(b,h) (((b)*2+(h))*HTB)
#define SB(b,h) ((4+(b)*2+(h))*HTB)
#define STAGE(bufoff,gbase,voff) do{ _Pragma("unroll") for(int _i=0;_i<2;++_i) \
    __builtin_amdgcn_global_load_lds((const unsigned*)((const char*)(gbase)+(voff)[_i]),(LAS unsigned*)(lds+(bufoff)+ldsw+_i*8192),16,0,0);}while(0)
#define LDA(dst,b,h) do{ _Pragma("unroll") for(int m=0;m<4;++m) _Pragma("unroll") for(int k=0;k<2;++k) dst[m][k]=*(const LAS bf16x8*)(lds+SA(b,h)+aoff+m*2048+k*1024);}while(0)
#define LDB(dst,b,h) do{ _Pragma("unroll") for(int n=0;n<2;++n) _Pragma("unroll") for(int k=0;k<2;++k) dst[n][k]=*(const LAS bf16x8*)(lds+SB(b,h)+boff+n*2048+k*1024);}while(0)
#define MMA(ai,bj,At_,Bt_) do{__builtin_amdgcn_s_setprio(1); \
    _Pragma("unroll") for(int m=0;m<4;++m) _Pragma("unroll") for(int n=0;n<2;++n) _Pragma("unroll") for(int k=0;k<2;++k) \
      acc[ai][bj][m][n]=__builtin_amdgcn_mfma_f32_16x16x32_bf16(Bt_[n][k],At_[m][k],acc[ai][bj][m][n],0,0,0); \
    __builtin_amdgcn_s_setprio(0);}while(0)
#define WAIT_V(n) asm volatile("s_waitcnt vmcnt(" #n ")":::"memory")
#define WAIT_L(n) asm volatile("s_waitcnt lgkmcnt(" #n ")":::"memory")
#define BAR __builtin_amdgcn_s_barrier()
#define SCHED __builtin_amdgcn_sched_barrier(0)
  f32x4 acc[2][2][4][2];
#pragma unroll
  for (int a = 0; a < 2; ++a)
#pragma unroll
    for (int b = 0; b < 2; ++b)
#pragma unroll
      for (int m = 0; m < 4; ++m)
#pragma unroll
        for (int n = 0; n < 2; ++n) acc[a][b][m][n] = (f32x4){0.f, 0.f, 0.f, 0.f};
  bf16x8 At[4][2], B0[2][2], B1[2][2];
  const int nt = K / BK;
  const char* cA = (const char*)jb.A + (size_t)brow * lda * 2; const char* cB = (const char*)jb.Bt + (size_t)bcol * ldb * 2;
  STAGE(SB(0,0),cB,voffB); STAGE(SA(0,0),cA,voffA);
  STAGE(SB(0,1),cB+hB,voffB); STAGE(SA(0,1),cA+hA,voffA);
  if (wr == 1) BAR;
  WAIT_V(4); BAR;
  STAGE(SB(1,0),cB+128,voffB); STAGE(SA(1,0),cA+128,voffA); STAGE(SB(1,1),cB+hB+128,voffB);
  WAIT_V(6); BAR;
  for (int t = 0; t < nt - 2; t += 2) {
    if (jb.mode == 7 && (t == 16 || t == 32)) {
      const int seg = (t >> 4) - 1;
      const bf16_t* gp = (const bf16_t*)jb.aux + (size_t)(brow + wr * 64 + fr) * NGATE + seg * 2048 + bcol + wc * 32 + fq * 8;
#pragma unroll
      for (int ai = 0; ai < 2; ++ai)
#pragma unroll
        for (int m = 0; m < 4; ++m)
#pragma unroll
          for (int bj = 0; bj < 2; ++bj)
#pragma unroll
            for (int n = 0; n < 2; ++n) {
              const bf16_t* g = gp + (size_t)(ai * HALF + m * 16) * NGATE + bj * HALF + n * 4;
              const f32x4 g0 = ld_bf4(g), g1 = ld_bf4(g + 2048);
#pragma unroll
              for (int e = 0; e < 4; ++e) acc[ai][bj][m][n][e] *= g0[e] * __builtin_amdgcn_rcpf(fmaxf(g1[e], 1e-30f));
            }
    }
    const char* a1 = cA + (size_t)(t + 1) * 128; const char* a2 = a1 + 128; const char* a3 = a2 + 128;
    const char* b2 = cB + (size_t)(t + 2) * 128; const char* b3 = b2 + 128;
    LDB(B0,0,0); SCHED; LDA(At,0,0); STAGE(SA(1,1),a1+hA,voffA);
    WAIT_L(8); BAR; WAIT_L(0); MMA(0,0,At,B0); BAR; SCHED;
    LDB(B1,0,1); STAGE(SB(0,0),b2,voffB);
    BAR; WAIT_L(0); MMA(0,1,At,B1); BAR;
    LDA(At,0,1); STAGE(SA(0,0),a2,voffA);
    BAR; WAIT_L(0); MMA(1,0,At,B0); BAR; SCHED;
    STAGE(SB(0,1),b2+hB,voffB);
    WAIT_V(6); BAR; MMA(1,1,At,B1); BAR;
    LDB(B0,1,0); SCHED; LDA(At,1,0); STAGE(SA(0,1),a2+hA,voffA);
    WAIT_L(8); BAR; WAIT_L(0); MMA(0,0,At,B0); BAR; SCHED;
    LDB(B1,1,1); STAGE(SB(1,0),b3,voffB);
    BAR; WAIT_L(0); MMA(0,1,At,B1); BAR;
    LDA(At,1,1); STAGE(SA(1,0),a3,voffA);
    BAR; WAIT_L(0); MMA(1,0,At,B0); BAR; SCHED;
    STAGE(SB(1,1),b3+hB,voffB);
    WAIT_V(6); BAR; MMA(1,1,At,B1); BAR;
  }
  { LDB(B0,0,0); LDA(At,0,0); STAGE(SA(1,1),cA+(size_t)(nt-1)*128+hA,voffA);
    BAR; WAIT_L(0); MMA(0,0,At,B0); BAR;
    LDB(B1,0,1); BAR; WAIT_L(0); MMA(0,1,At,B1); BAR;
    LDA(At,0,1); WAIT_V(4); BAR; WAIT_L(0); MMA(1,0,At,B0); MMA(1,1,At,B1); BAR; }
  { LDB(B0,1,0); LDA(At,1,0); WAIT_V(2); BAR; WAIT_L(0); MMA(0,0,At,B0); BAR;
    LDB(B1,1,1); WAIT_V(0); BAR; WAIT_L(0); MMA(0,1,At,B1); BAR;
    LDA(At,1,1); BAR; WAIT_L(0); MMA(1,0,At,B0); MMA(1,1,At,B1); BAR; }
  if (wr == 0) BAR;
#pragma unroll
  for (int ai = 0; ai < 2; ++ai)
#pragma unroll
    for (int m = 0; m < 4; ++m)
#pragma unroll
      for (int bj = 0; bj < 2; ++bj)
        gemm_epi(jb, brow + ai * HALF + wr * 64 + m * 16 + fr, bcol + bj * HALF + wc * 32 + fq * 8, acc[ai][bj][m][0], acc[ai][bj][m][1]);
  __syncthreads();
#undef SA
#undef SB
#undef STAGE
#undef LDA
#undef LDB
#undef MMA
}

DEVI void gemm_job(const GJob& jb, int& cursor, int c, int G, unsigned char* lds) {
  const int nM = T / BM, nN = jb.N / BM, ntile = nM * nN;
  if (c >= 0) {
    const int slot = ((G & 7) == 0) ? (c & 7) * (G >> 3) + (c >> 3) : c;
    int first = (slot - cursor % G + G) % G;
    for (int i = first; i < ntile; i += G) {
      const int nig = WGM * nN, gid = i / nig, fm = gid * WGM, gsz = (nM - fm) < WGM ? (nM - fm) : WGM;
      const int pm = fm + ((i % nig) % gsz), pn = (i % nig) / gsz;
      gemm_tile(jb, pm * BM, pn * BM, lds);
    }
  }
  if (!jb.keep) cursor += ntile;
}

DEVI void convT(const float* __restrict__ src, int src_ld, int k_real, int n_real, bf16_t* __restrict__ dst, int dld, int k_pad, int n_pad, int& cursor, int c, int G, unsigned char* lds) {
  float* tile = (float*)lds;
  const int tk = k_pad / 128, tn = n_pad / 128, nt = tk * tn, tid = ltid(), w = tid >> 6, lane = tid & 63;
  int first = (c - cursor % G + G) % G;
  for (int i = first; i < nt; i += G) {
    const int n0 = (i / tk) * 128, k0 = (i % tk) * 128;
    { const int n = n0 + lane * 2; const bool nok = n < n_real;
      f32x2 v[16];
#pragma unroll
      for (int r = 0; r < 16; ++r) {
        const int k = k0 + w * 16 + r;
        v[r] = (f32x2){0.f, 0.f};
        if (nok && k < k_real) v[r] = __builtin_nontemporal_load((const f32x2*)(src + (size_t)k * src_ld + n));
      }
#pragma unroll
      for (int r = 0; r < 16; ++r) *(f32x2*)(tile + (w * 16 + r) * 130 + lane * 2) = v[r]; }
    __syncthreads();
    { const int n = tid >> 2, q = tid & 3;
#pragma unroll
      for (int jj = 0; jj < 4; ++jj) {
        const int k8 = (jj * 4 + q) * 8;
        const float* tp = tile + k8 * 130 + n;
        u32x4 o; o.x = cvt_pk_bf16(tp[0], tp[130]); o.y = cvt_pk_bf16(tp[260], tp[390]); o.z = cvt_pk_bf16(tp[520], tp[650]); o.w = cvt_pk_bf16(tp[780], tp[910]);
        *(u32x4*)(dst + (size_t)(n0 + n) * dld + k0 + k8) = o;
      } }
    __syncthreads();
  }
  cursor += nt;
}

__device__ void convert_layer(const Params& P, int l, unsigned mask, int c, int G, unsigned char* lds) {
  unsigned char* ws = P.ws;
  int cur = 0;
  for (int j = 0; j < 18; ++j) {
    if (!((mask >> j) & 1u)) continue;
    const float* src = nullptr; bf16_t* dst = nullptr; int sld = 0, kr = 0, nr = 0, kp = 0, np = 0;
    const float* w_in = (const float*)P.in[7] + (size_t)l * D * NIN;
    bf16_t* wtin = (bf16_t*)(ws + WT_IN + (size_t)(l & 1) * WTIN_BYTES);
    switch (j) {
      case 0: src = w_in; sld = NIN; kr = 2048; nr = 3520; dst = wtin; kp = 2048; np = 3584; break;
      case 1: src = w_in + 3520; sld = NIN; kr = 2048; nr = 512; dst = wtin + (size_t)3584 * 2048; kp = 2048; np = 512; break;
      case 2: src = w_in + 4032; sld = NIN; kr = 2048; nr = 576; dst = wtin + (size_t)4096 * 2048; kp = 2048; np = 768; break;
      case 3: src = w_in + 4608; sld = NIN; kr = 2048; nr = 2048; dst = wtin + (size_t)4864 * 2048; kp = 2048; np = 2048; break;
      case 4: src = w_in + 6656; sld = NIN; kr = 2048; nr = 6144; dst = wtin + (size_t)6912 * 2048; kp = 2048; np = 6144; break;
      case 5: src = (const float*)P.in[24] + (size_t)l * 512 * 1536; sld = 1536; kr = 512; nr = 1536; dst = (bf16_t*)(ws + WT_UQ); kp = 512; np = 1536; break;
      case 6: src = (const float*)P.in[25] + (size_t)l * 512 * 2048; sld = 2048; kr = 512; nr = 2048; dst = (bf16_t*)(ws + WT_UKV); kp = 512; np = 2048; break;
      case 7: src = (const float*)P.in[10] + (size_t)l * 96 * 1024; sld = 1024; kr = 96; nr = 1024; dst = (bf16_t*)(ws + WT_LW); kp = 256; np = 1024; break;
      case 8: src = (const float*)P.in[12] + (size_t)l * 96 * 1024; sld = 1024; kr = 96; nr = 1024; dst = (bf16_t*)(ws + WT_LA); kp = 256; np = 1024; break;
      case 9: src = (const float*)P.in[13] + (size_t)l * 256 * 1024; sld = 1024; kr = 256; nr = 1024; dst = (bf16_t*)(ws + WT_LG); kp = 256; np = 1024; break;
      case 10: if (l > 0) { src = (const float*)P.in[20] + (size_t)(l - 1) * 1024 * 64; sld = 64; kr = 1024; nr = 64; dst = (bf16_t*)(ws + WT_V1); kp = 1024; np = 256; } break;
      case 11: if (l > 0) { src = (const float*)P.in[21] + (size_t)(l - 1) * 64 * 1024; sld = 1024; kr = 64; nr = 1024; dst = (bf16_t*)(ws + WT_V2); kp = 256; np = 1024; } break;
      case 12: src = (const float*)P.in[34] + (size_t)l * 1024 * 2048; sld = 2048; kr = 1024; nr = 2048; dst = (bf16_t*)(ws + WT_BR); kp = 1024; np = 2048; break;
      case 13: src = (const float*)P.in[35] + (size_t)l * 1024 * 2048; sld = 2048; kr = 1024; nr = 2048; dst = (bf16_t*)(ws + WT_BR) + 1024; kp = 1024; np = 2048; break;
      case 14: src = (const float*)P.in[36] + (size_t)l * 1024 * 2048; sld = 2048; kr = 1024; nr = 2048; dst = (bf16_t*)(ws + WT_BR) + 2048; kp = 1024; np = 2048; break;
      case 15: src = (const float*)P.in[37] + (size_t)l * 2048 * 2048; sld = 2048; kr = 2048; nr = 2048; dst = (bf16_t*)(ws + WT_OUT); kp = 2048; np = 2048; break;
      case 16: src = (const float*)P.in[38] + (size_t)l * 2048 * 11264; sld = 11264; kr = 2048; nr = 11264; dst = (bf16_t*)(ws + WT_UP); kp = 2048; np = 11264; break;
      default: src = (const float*)P.in[41] + (size_t)l * DFF * 2048; sld = 2048; kr = DFF; nr = 2048; dst = (bf16_t*)(ws + WT_DN); kp = DFF; np = 2048; break;
    }
    if (src) convT(src, sld, kr, nr, dst, (j >= 12 && j <= 14) ? 3072 : kp, kp, np, cur, c, G, lds);
  }
  if ((mask >> 18) & 1u) {
    const float* sgw = (const float*)P.in[32] + (size_t)l * 8 * 128 * 128;
    bf16_t* wsg = (bf16_t*)(ws + WT_SG);
    for (int i = c * 512 + ltid(); i < 8 * 128 * 128; i += G * 512) {
      int s = i & 127, t = (i >> 7) & 127;
      wsg[i] = f2bf(s <= t ? sgw[i] : 0.f);
    }
  }
}

__device__ const float ROPE_INV[32] = {1.0f, 0.749894202f, 0.562341332f, 0.421696514f, 0.316227764f, 0.237137377f, 0.177827939f, 0.133352146f, 0.100000001f, 0.0749894232f, 0.0562341325f, 0.0421696492f, 0.0316227749f, 0.0237137377f, 0.0177827943f, 0.013335214f, 0.00999999978f, 0.00749894232f, 0.00562341325f, 0.00421696482f, 0.00316227763f, 0.00237137382f, 0.00177827943f, 0.00133352145f, 0.00100000005f, 0.000749894185f, 0.000562341302f, 0.000421696517f, 0.000316227757f, 0.00023713737f, 0.00017782794f, 0.00013335215f};
__device__ void phase_init(const Params& P, unsigned char* lds) {
  const int tid = ltid();
  const float* cvec = (const float*)P.in[1];
  for (int it = lbid(); it < 192; it += gridDim.x) {
    const int l = it / 96, rem = it % 96, cc = rem % 3, kc = rem / 3;
    const int col = cc * 4096 + tid * 4;
    const float* w = (const float*)P.in[3] + (size_t)l * D * 12288 + col;
    f32x4 acc0 = {0.f, 0.f, 0.f, 0.f}, acc1 = acc0;
#pragma unroll 8
    for (int i = kc * 64; i < kc * 64 + 64; ++i) {
      float cv = cvec[i]; float s = cv * sigmoidf_(cv);
      acc0 += s * __builtin_nontemporal_load((const f32x4*)(w + (size_t)i * 12288));
      acc1 += s * __builtin_nontemporal_load((const f32x4*)(w + (size_t)i * 12288 + 2048));
    }
    if (kc == 0) { acc0 += *(const f32x4*)((const float*)P.in[4] + l * 12288 + col); acc1 += *(const f32x4*)((const float*)P.in[4] + l * 12288 + col + 2048); }
    float* mo = (float*)(P.ws + WS_MOD) + l * 12288 + col;
    atomicAdd(mo, acc0[0]); atomicAdd(mo + 1, acc0[1]); atomicAdd(mo + 2, acc0[2]); atomicAdd(mo + 3, acc0[3]);
    atomicAdd(mo + 2048, acc1[0]); atomicAdd(mo + 2049, acc1[1]); atomicAdd(mo + 2050, acc1[2]); atomicAdd(mo + 2051, acc1[3]);
  }
  const int* pos = (const int*)P.in[2];
  float* cosb = (float*)(P.ws + WS_COS); float* sinb = (float*)(P.ws + WS_SIN);
  for (int i = lbid() * 512 + tid; i < T * 32; i += gridDim.x * 512) {
    int t = i >> 5, j = i & 31;
    float inv = ROPE_INV[j];
    float ang = (float)pos[t] * inv;
    double rev = (double)ang * 0.15915494309189535;
    rev -= rint(rev);
    cosb[i] = __builtin_amdgcn_cosf((float)rev);
    sinb[i] = __builtin_amdgcn_sinf((float)rev);
  }
  __syncthreads();
}

__device__ void phase_h(const float* __restrict__ x, const float* __restrict__ g, const float* __restrict__ sh, const float* __restrict__ sc, bf16_t* __restrict__ H) {
  const int wave = ltid() >> 6, lane = ltid() & 63;
  for (int row = lbid() * 8 + wave; row < T; row += gridDim.x * 8) {
    const float* xr = x + (size_t)row * D;
    f32x4 v[8]; float ss = 0.f;
#pragma unroll
    for (int i = 0; i < 8; ++i) { v[i] = *(const f32x4*)(xr + i * 256 + lane * 4); ss += v[i][0] * v[i][0] + v[i][1] * v[i][1] + v[i][2] * v[i][2] + v[i][3] * v[i][3]; }
    ss = wave_sum(ss);
    const float rstd = rsqrtf(ss * (1.f / D) + 1e-6f);
#pragma unroll
    for (int i = 0; i < 8; ++i) {
      const int c = i * 256 + lane * 4;
      f32x4 gg = *(const f32x4*)(g + c), s1 = *(const f32x4*)(sc + c), s0 = *(const f32x4*)(sh + c);
      f32x4 o = v[i] * rstd * gg * (1.f + s1) + s0;
      st_bf4(H + (size_t)row * D + c, o);
    }
  }
}

__device__ void phase_prep1(const Params& P, int l) {
  unsigned char* ws = P.ws;
  const bf16_t* Pb = (const bf16_t*)(ws + A_P);
  const float* mu = (const float*)P.in[8] + l * 3520;
  bf16_t* AL = (bf16_t*)(ws + A_AL); bf16_t* VB = (bf16_t*)(ws + A_VB);
  bf16_t* QL = (bf16_t*)(ws + A_QL); bf16_t* CKV = (bf16_t*)(ws + A_CKV); bf16_t* KR = (bf16_t*)(ws + A_KR);
  bf16_t* U = (bf16_t*)(ws + A_U); bf16_t* VN = (bf16_t*)(ws + A_VN);
  const float* cosb = (const float*)(ws + WS_COS); const float* sinb = (const float*)(ws + WS_SIN);
  const float* qn = (const float*)P.in[22] + l * 512; const float* kvn = (const float*)P.in[23] + l * 512;
  const float* knr = (const float*)P.in[29] + l * 64;
  const float* lnw = (const float*)P.in[30] + l * 1024; const float* lnb = (const float*)P.in[31] + l * 1024;
  const int wave = ltid() >> 6, lane = ltid() & 63;
  for (int t = lbid() * 8 + wave; t < T; t += gridDim.x * 8) {
    const bf16_t* pc = Pb + (size_t)t * PW; const bf16_t* pp = pc - PW; const bool hp = t > 0;
#pragma unroll
    for (int gq = 0; gq < 3; ++gq) {
      const int idx = (gq * 64 + lane) * 4, seg = idx >> 8, j = idx & 255;
      f32x4 val = {0.f, 0.f, 0.f, 0.f};
      if (seg == 2 || j < 96) {
        const int col = seg == 0 ? 3072 + j : (seg == 1 ? 3168 + j : 3264 + j);
        const f32x4 cur = ld_bf4(pc + col), prev = hp ? ld_bf4(pp + col) : (f32x4){0.f, 0.f, 0.f, 0.f};
        const f32x4 p = cur + (prev - cur) * *(const f32x4*)(mu + col);
#pragma unroll
        for (int e = 0; e < 4; ++e) val[e] = seg == 0 ? tanhf_(p[e]) : (seg == 1 ? p[e] : sigmoidf_(p[e]));
      }
      st_bf4(AL + (size_t)t * 768 + idx, val);
    }
    if (l > 0) {
#pragma unroll
      for (int i = 0; i < 4; ++i) {
        const int c = i * 256 + lane * 4, col = 2048 + c;
        f32x4 cur = ld_bf4(pc + col), prev = hp ? ld_bf4(pp + col) : (f32x4){0.f, 0.f, 0.f, 0.f};
        f32x4 m = *(const f32x4*)(mu + col);
        st_bf4(VB + (size_t)t * 1024 + c, cur + (prev - cur) * m);
      }
    }
#pragma unroll
    for (int which = 0; which < 2; ++which) {
      const int col = (which == 0 ? PC_DQ : PC_CKV) + lane * 8;
      f32x4 a = ld_bf4(pc + col), b = ld_bf4(pc + col + 4);
      float ss = a[0] * a[0] + a[1] * a[1] + a[2] * a[2] + a[3] * a[3] + b[0] * b[0] + b[1] * b[1] + b[2] * b[2] + b[3] * b[3];
      ss = wave_sum(ss);
      const float rstd = rsqrtf(ss * (1.f / 512.f) + 1e-6f);
      const float* gn = (which == 0 ? qn : kvn) + lane * 8;
      bf16_t* dst = (which == 0 ? QL : CKV) + (size_t)t * 512 + lane * 8;
      st_bf4(dst, a * rstd * *(const f32x4*)gn); st_bf4(dst + 4, b * rstd * *(const f32x4*)(gn + 4));
    }
    {
      float xv = bf2f(pc[PC_KR + lane]);
      float ss = wave_sum(xv * xv);
      float y = xv * rsqrtf(ss * (1.f / 64.f) + 1e-6f) * knr[lane];
      float oth = __shfl_xor(y, 32);
      const int j = lane & 31; float cs = cosb[t * 32 + j], sn = sinb[t * 32 + j];
      float o = lane < 32 ? (y * cs - oth * sn) : (oth * sn + y * cs);
      KR[(size_t)t * 64 + lane] = f2bf(o);
    }
    {
      f32x4 uu[4], vv[4]; float s1 = 0.f;
#pragma unroll
      for (int i = 0; i < 4; ++i) {
        const int c = i * 256 + lane * 4;
        uu[i] = ld_bf4(pc + PC_U + c); vv[i] = ld_bf4(pc + PC_VS + c);
#pragma unroll
        for (int e = 0; e < 4; ++e) { uu[i][e] = geluf_(uu[i][e]); vv[i][e] = geluf_(vv[i][e]); s1 += vv[i][e]; }
      }
      s1 = wave_sum(s1); const float mean = s1 * (1.f / 1024.f); float s2 = 0.f;
#pragma unroll
      for (int i = 0; i < 4; ++i)
#pragma unroll
        for (int e = 0; e < 4; ++e) { float d = vv[i][e] - mean; s2 += d * d; }
      s2 = wave_sum(s2); const float rstd = rsqrtf(s2 * (1.f / 1024.f) + 1e-5f);
#pragma unroll
      for (int i = 0; i < 4; ++i) {
        const int c = i * 256 + lane * 4;
        st_bf4(U + (size_t)t * 1024 + c, uu[i]);
        st_bf4(VN + (size_t)t * 1024 + c, (vv[i] - mean) * rstd * *(const f32x4*)(lnw + c) + *(const f32x4*)(lnb + c));
      }
    }
  }
}

__device__ void phase_prep2(const Params& P, int l, unsigned char* lds) {
  unsigned char* ws = P.ws;
  const bf16_t* Pb = (const bf16_t*)(ws + A_P);
  const float* mu = (const float*)P.in[8] + l * 3520;
  const float* w0 = (const float*)P.in[9] + l * 1024; const float* a0 = (const float*)P.in[11] + l * 1024;
  const float* k_k = (const float*)P.in[14] + l * 1024; const float* k_a = (const float*)P.in[15] + l * 1024;
  const float* v0 = (const float*)P.in[19];
  float* LW = (float*)(ws + A_LW); float* LA = (float*)(ws + A_LA); float* VG = (float*)(ws + A_VG); float* VF = (float*)(ws + WS_VF);
  float* KK = (float*)(ws + A_KK); bf16_t* KH = (bf16_t*)(ws + A_KH); bf16_t* R = (bf16_t*)(ws + A_R);
  const int wave = ltid() >> 6, lane = ltid() & 63, tid = ltid();
  const f32x4 z4 = {0.f, 0.f, 0.f, 0.f};
  for (int t = lbid() * 8 + wave; t < T; t += gridDim.x * 8) {
    const bf16_t* pc = Pb + (size_t)t * PW; const bf16_t* pp = pc - PW; const bool hp = t > 0;
#pragma unroll
    for (int i = 0; i < 4; ++i) {
      const int c = i * 256 + lane * 4; const size_t o = (size_t)t * 1024 + c;
      f32x4 rc = ld_bf4(pc + c), kc = ld_bf4(pc + 1024 + c), vc = ld_bf4(pc + 2048 + c);
      f32x4 rp = hp ? ld_bf4(pp + c) : z4, kp = hp ? ld_bf4(pp + 1024 + c) : z4, vp = hp ? ld_bf4(pp + 2048 + c) : z4;
      f32x4 r = rc + (rp - rc) * *(const f32x4*)(mu + c);
      f32x4 k = kc + (kp - kc) * *(const f32x4*)(mu + 1024 + c);
      f32x4 v = vc + (vp - vc) * *(const f32x4*)(mu + 2048 + c);
      if (l > 0) {
        f32x4 vg = *(const f32x4*)(VG + o), vf = *(const f32x4*)(VF + o), vz = *(const f32x4*)(v0 + c);
#pragma unroll
        for (int e = 0; e < 4; ++e) v[e] = v[e] + (vf[e] - v[e]) * sigmoidf_(vz[e] + vg[e]);
      } else { *(f32x4*)(VF + o) = v; }
      f32x4 lw = *(const f32x4*)(LW + o), la = *(const f32x4*)(LA + o);
      f32x4 w0v = *(const f32x4*)(w0 + c), a0v = *(const f32x4*)(a0 + c), kkv = *(const f32x4*)(k_k + c), kav = *(const f32x4*)(k_a + c);
      f32x4 dec, al, kk, kh; float ss = 0.f;
#pragma unroll
      for (int e = 0; e < 4; ++e) {
        float z = w0v[e] + lw[e];
        float sp = fmaxf(-z, 0.f) + __logf(1.f + __expf(-fabsf(z)));
        float wl = -sp - 0.5f;
        dec[e] = __expf(-__expf(wl));
        al[e] = sigmoidf_(a0v[e] + la[e]);
        kk[e] = k[e] * kkv[e]; ss += kk[e] * kk[e];
        kh[e] = k[e] * (1.f + (al[e] - 1.f) * kav[e]);
      }
      ss = sum16(ss);
      const float inv = 1.f / fmaxf(sqrtf(ss), 1e-12f);
      kk = kk * inv;
      *(f32x4*)(LW + o) = dec; *(f32x4*)(LA + o) = -(kk * al); *(f32x4*)(VG + o) = v; *(f32x4*)(KK + o) = kk;
      st_bf4(KH + o, kh); st_bf4(R + o, r);
    }
  }
  const bf16_t* QRAW = (const bf16_t*)(ws + A_QRAW); const bf16_t* KVRAW = (const bf16_t*)(ws + A_KVRAW); const bf16_t* KR = (const bf16_t*)(ws + A_KR);
  bf16_t* Q = (bf16_t*)(ws + A_Q); bf16_t* Kd = (bf16_t*)(ws + A_K); bf16_t* VT = (bf16_t*)(ws + A_VT);
  const float* cosb = (const float*)(ws + WS_COS); const float* sinb = (const float*)(ws + WS_SIN);
  const float* qnn = (const float*)P.in[26] + l * 128; const float* qnr = (const float*)P.in[27] + l * 64; const float* knn = (const float*)P.in[28] + l * 128;
  const float QS = 0.07216878364870322f * 1.4426950408889634f;
  for (int t = lbid() * 8 + wave; t < T; t += gridDim.x * 8) {
    const int j = lane & 31; const float cs = cosb[t * 32 + j], sn = sinb[t * 32 + j];
    const unsigned krv = KR[(size_t)t * 64 + lane];
    for (int h = 0; h < 8; ++h) {
      const bf16_t* qr = QRAW + (size_t)t * 1536 + h * 192;
      unsigned u = *(const unsigned*)(qr + lane * 2);
      float a = bf_lo(u), b = bf_hi(u);
      float ss = wave_sum(a * a + b * b); float rstd = rsqrtf(ss * (1.f / 128.f) + 1e-6f);
      bf16_t* qo = Q + ((size_t)h * T + t) * 192;
      *(unsigned*)(qo + lane * 2) = cvt_pk_bf16(a * rstd * qnn[lane * 2] * QS, b * rstd * qnn[lane * 2 + 1] * QS);
      float xr = bf2f(qr[128 + lane]);
      float s2 = wave_sum(xr * xr); float y = xr * rsqrtf(s2 * (1.f / 64.f) + 1e-6f) * qnr[lane];
      float oth = __shfl_xor(y, 32);
      float o = lane < 32 ? (y * cs - oth * sn) : (oth * sn + y * cs);
      qo[128 + lane] = f2bf(o * QS);
      const bf16_t* kr = KVRAW + (size_t)t * 2048 + h * 256;
      unsigned uk = *(const unsigned*)(kr + lane * 2);
      float ka = bf_lo(uk), kb = bf_hi(uk);
      float sk = wave_sum(ka * ka + kb * kb); float rk = rsqrtf(sk * (1.f / 128.f) + 1e-6f);
      bf16_t* ko = Kd + ((size_t)h * T + t) * 192;
      *(unsigned*)(ko + lane * 2) = cvt_pk_bf16(ka * rk * knn[lane * 2], kb * rk * knn[lane * 2 + 1]);
      ko[128 + lane] = (bf16_t)krv;
    }
  }
  bf16_t* tl = (bf16_t*)lds;
  for (int it = lbid(); it < 8 * (T / 64); it += gridDim.x) {
    const int h = it & 7, tb = it >> 3;
    __syncthreads();
    { const int tt = tid >> 3, dc = (tid & 7) * 16;
      const bf16_t* src = KVRAW + (size_t)(tb * 64 + tt) * 2048 + h * 256 + 128 + dc;
      *(u32x4*)(tl + tt * 136 + dc) = *(const u32x4*)src; *(u32x4*)(tl + tt * 136 + dc + 8) = *(const u32x4*)(src + 8); }
    __syncthreads();
    { const int dv = tid >> 2, tq = (tid & 3) * 16;
      unsigned o[8];
#pragma unroll
      for (int i = 0; i < 8; ++i) o[i] = (unsigned)tl[(tq + 2 * i) * 136 + dv] | ((unsigned)tl[(tq + 2 * i + 1) * 136 + dv] << 16);
      bf16_t* dst = VT + (((size_t)h * (T / 64) + tb) * 128 + dv) * 64 + tq;
      *(u32x4*)dst = (u32x4){o[0], o[1], o[2], o[3]}; *(u32x4*)(dst + 8) = (u32x4){o[4], o[5], o[6], o[7]}; }
  }
}

constexpr int SC_CH = 32, SC_STEP = 336, SC_STAGE = SC_CH * SC_STEP;
__device__ void scan_block(const Params& P, int sb, unsigned char* lds) {
  unsigned char* ws = P.ws;
  const float* LW = (const float*)(ws + A_LW); const float* LA = (const float*)(ws + A_LA); const float* VG = (const float*)(ws + A_VG);
  const float* KK = (const float*)(ws + A_KK); const bf16_t* KH = (const bf16_t*)(ws + A_KH); const bf16_t* R = (const bf16_t*)(ws + A_R);
  float* Y = (float*)(ws + A_YSC);
  float* buf = (float*)lds;
  const int head = sb >> 2, rg = sb & 3, tid = ltid();
  const bool loader = tid >= 256; const int lt = tid - 256;
  const int lane = tid & 63, wv = (tid >> 6) & 3, ks = lane & 15, myrow = wv * 4 + (lane >> 4);
  f32x4 S = {0.f, 0.f, 0.f, 0.f};
  const int hb = head * 64;
  struct Batch { f32x4 g0[2], g1[2], g2[2], gv; u32x4 h0, h1; };
  auto ld_chunk = [&](Batch& B, int c) {
    const int t0 = c * SC_CH;
#pragma unroll
    for (int i = 0; i < 2; ++i) { const int idx = lt + i * 256, st = idx >> 4, c4 = (idx & 15) * 4; const size_t o = (size_t)(t0 + st) * 1024 + hb + c4;
      B.g0[i] = *(const f32x4*)(LW + o); B.g1[i] = *(const f32x4*)(KK + o); B.g2[i] = *(const f32x4*)(LA + o); }
    { const int st = lt >> 3, c8 = (lt & 7) * 8; const size_t o = (size_t)(t0 + st) * 1024 + hb + c8; B.h0 = *(const u32x4*)(KH + o); B.h1 = *(const u32x4*)(R + o); }
    if (lt < 128) { const int st = lt >> 2, r4 = (lt & 3) * 4; B.gv = *(const f32x4*)(VG + (size_t)(t0 + st) * 1024 + hb + rg * 16 + r4); }
  };
  auto st_chunk = [&](const Batch& B, int s) {
    float* b = buf + s * SC_STAGE;
#pragma unroll
    for (int i = 0; i < 2; ++i) { const int idx = lt + i * 256, st = idx >> 4, c4 = (idx & 15) * 4; float* d = b + st * SC_STEP + c4;
      *(f32x4*)(d) = B.g0[i]; *(f32x4*)(d + 64) = B.g1[i]; *(f32x4*)(d + 128) = B.g2[i]; }
    { const int st = lt >> 3, c8 = (lt & 7) * 8; float* d = b + st * SC_STEP + c8;
      *(f32x4*)(d + 192) = (f32x4){bf_lo(B.h0.x), bf_hi(B.h0.x), bf_lo(B.h0.y), bf_hi(B.h0.y)}; *(f32x4*)(d + 196) = (f32x4){bf_lo(B.h0.z), bf_hi(B.h0.z), bf_lo(B.h0.w), bf_hi(B.h0.w)};
      *(f32x4*)(d + 256) = (f32x4){bf_lo(B.h1.x), bf_hi(B.h1.x), bf_lo(B.h1.y), bf_hi(B.h1.y)}; *(f32x4*)(d + 260) = (f32x4){bf_lo(B.h1.z), bf_hi(B.h1.z), bf_lo(B.h1.w), bf_hi(B.h1.w)}; }
    if (lt < 128) { const int st = lt >> 2, r4 = (lt & 3) * 4; *(f32x4*)(b + st * SC_STEP + 320 + r4) = B.gv; }
  };
  const int NCH = T / SC_CH;
  __syncthreads();
  if (loader) {
    Batch b0, b1, b2, b3;
    ld_chunk(b0, 0); st_chunk(b0, 0); ld_chunk(b1, 1); ld_chunk(b2, 2); ld_chunk(b3, 3); ld_chunk(b0, 4);
    __syncthreads();
    for (int c = 0; c < NCH; c += 4) {
      if (c + 1 < NCH) st_chunk(b1, (c + 1) & 1);
      if (c + 5 < NCH) ld_chunk(b1, c + 5);
      __syncthreads();
      if (c + 2 < NCH) st_chunk(b2, (c + 2) & 1);
      if (c + 6 < NCH) ld_chunk(b2, c + 6);
      __syncthreads();
      if (c + 3 < NCH) st_chunk(b3, (c + 3) & 1);
      if (c + 7 < NCH) ld_chunk(b3, c + 7);
      __syncthreads();
      if (c + 4 < NCH) st_chunk(b0, (c + 4) & 1);
      if (c + 8 < NCH) ld_chunk(b0, c + 8);
      __syncthreads();
    }
  } else {
    __builtin_amdgcn_s_setprio(2);
    __syncthreads();
    for (int c = 0; c < NCH; ++c) {
      const float* b = buf + (c & 1) * SC_STAGE;
      const float* q = b + ks * 4;
      const float* qv = b + 320 + myrow;
      float* yo = Y + (size_t)(c * SC_CH + ks) * 1024 + hb + rg * 16 + myrow;
      f32x4 w4 = *(const f32x4*)(q), k4 = *(const f32x4*)(q + 64), b4 = *(const f32x4*)(q + 128), kh4 = *(const f32x4*)(q + 192), r4 = *(const f32x4*)(q + 256);
      float v = qv[0];
      float yk = 0.f, ypart = 0.f;
#pragma unroll
      for (int s = 0; s < SC_CH; ++s) {
        f32x4 w4n, k4n, b4n, kh4n, r4n; float vn;
        if (s + 1 < SC_CH) {
          const float* qn = q + (s + 1) * SC_STEP;
          w4n = *(const f32x4*)(qn); k4n = *(const f32x4*)(qn + 64); b4n = *(const f32x4*)(qn + 128); kh4n = *(const f32x4*)(qn + 192); r4n = *(const f32x4*)(qn + 256);
          vn = qv[(s + 1) * SC_STEP];
        }
        __builtin_amdgcn_sched_barrier(0);
        if (s > 0) {
          const float y = dpp_allreduce16(ypart);
          yk = (ks == ((s - 1) & 15)) ? y : yk;
          if (((s - 1) & 15) == 15) yo[(size_t)(s - 16) * 1024] = yk;
        }
        const f32x2 pp = (f32x2){S[0], S[1]} * (f32x2){k4[0], k4[1]} + (f32x2){S[2], S[3]} * (f32x2){k4[2], k4[3]};
        const f32x4 A = S * w4 + v * kh4;
        const float ar = dpp_allreduce16(pp.x + pp.y);
        S = A + ar * b4;
        const f32x2 yy = (f32x2){S[0], S[1]} * (f32x2){r4[0], r4[1]} + (f32x2){S[2], S[3]} * (f32x2){r4[2], r4[3]};
        ypart = yy.x + yy.y;
        if (s + 1 < SC_CH) { w4 = w4n; k4 = k4n; b4 = b4n; kh4 = kh4n; r4 = r4n; v = vn; }
      }
      { const float y = dpp_allreduce16(ypart); yk = (ks == 15) ? y : yk; yo[(size_t)16 * 1024] = yk; }
      __syncthreads();
    }
    __builtin_amdgcn_s_setprio(0);
  }
}

constexpr int AT_KROW = 400, AT_VROW = 144, AT_K = 64 * AT_KROW, AT_STAGE = AT_K + 128 * AT_VROW;
__device__ void attn_block(const Params& P, int h, int qb, unsigned char* lds) {
  unsigned char* ws = P.ws;
  const bf16_t* Q = (const bf16_t*)(ws + A_Q); const bf16_t* Kd = (const bf16_t*)(ws + A_K); const bf16_t* VT = (const bf16_t*)(ws + A_VT);
  bf16_t* Y3 = (bf16_t*)(ws + A_Y3);
  const int tid = ltid(), w = tid >> 6, lane = tid & 63, fr = lane & 15, fq = lane >> 4;
  const int q0 = qb * 256, wq0 = q0 + w * 32;
  bf16x8 qf[2][6];
#pragma unroll
  for (int r2 = 0; r2 < 2; ++r2) {
    const bf16_t* qg = Q + ((size_t)h * T + wq0 + r2 * 16 + fr) * 192 + fq * 8;
#pragma unroll
    for (int kk = 0; kk < 6; ++kk) qf[r2][kk] = *(const bf16x8*)(qg + kk * 32);
  }
  f32x4 o[2][8];
#pragma unroll
  for (int r2 = 0; r2 < 2; ++r2)
#pragma unroll
    for (int n = 0; n < 8; ++n) o[r2][n] = (f32x4){0.f, 0.f, 0.f, 0.f};
  float m[2] = {-1e30f, -1e30f}, l[2] = {0.f, 0.f};
  const int ntiles = (q0 + 256) / 64;
  const bf16_t* Kh = Kd + (size_t)h * T * 192; const bf16_t* Vh = VT + (size_t)h * 128 * T;
  u32x4 kr[3], vr[2];
  auto ld_tile = [&](int kt) {
    const int k0 = kt * 64;
#pragma unroll
    for (int i = 0; i < 3; ++i) { const int c = tid + i * 512, row = c / 24, cc = c % 24; kr[i] = *(const u32x4*)(Kh + (size_t)(k0 + row) * 192 + cc * 8); }
#pragma unroll
    for (int i = 0; i < 2; ++i) { const int c = tid + i * 512; vr[i] = *(const u32x4*)(Vh + (size_t)kt * 8192 + c * 8); }
  };
  auto st_tile = [&](int s) {
    unsigned char* b = lds + s * AT_STAGE;
#pragma unroll
    for (int i = 0; i < 3; ++i) { const int c = tid + i * 512, row = c / 24, cc = c % 24; *(u32x4*)(b + row * AT_KROW + cc * 16) = kr[i]; }
#pragma unroll
    for (int i = 0; i < 2; ++i) { const int c = tid + i * 512, dv = c >> 3, cc = c & 7, x = dv & 31, row = (dv & ~31) + ((x >> 2) & 1) * 16 + (x >> 3) * 4 + (x & 3);
      *(u32x4*)(b + AT_K + row * AT_VROW + cc * 16) = vr[i]; }
  };
  __syncthreads();
  ld_tile(0); st_tile(0);
  __syncthreads();
  for (int kt = 0; kt < ntiles; ++kt) {
    const int k0 = kt * 64;
    if (kt + 1 < ntiles) ld_tile(kt + 1);
    if (k0 <= wq0 + 31) {
      const unsigned char* kb = lds + (kt & 1) * AT_STAGE; const unsigned char* vb = kb + AT_K;
      f32x4 s[2][4];
#pragma unroll
      for (int sub = 0; sub < 4; ++sub) {
        s[0][sub] = (f32x4){0.f, 0.f, 0.f, 0.f}; s[1][sub] = s[0][sub];
#pragma unroll
        for (int kk = 0; kk < 6; ++kk) {
          bf16x8 a = *(const bf16x8*)(kb + (sub * 16 + fr) * AT_KROW + (kk * 32 + fq * 8) * 2);
          s[0][sub] = __builtin_amdgcn_mfma_f32_16x16x32_bf16(a, qf[0][kk], s[0][sub], 0, 0, 0);
          s[1][sub] = __builtin_amdgcn_mfma_f32_16x16x32_bf16(a, qf[1][kk], s[1][sub], 0, 0, 0);
        }
      }
      u32x4 pk[2][2];
#pragma unroll
      for (int r2 = 0; r2 < 2; ++r2) {
        const int qrow = wq0 + r2 * 16 + fr;
        if (k0 + 63 > wq0 + r2 * 16) {
#pragma unroll
          for (int sub = 0; sub < 4; ++sub)
#pragma unroll
            for (int j = 0; j < 4; ++j) if (k0 + sub * 16 + fq * 4 + j > qrow) s[r2][sub][j] = -1e30f;
        }
        float mx = -1e30f;
#pragma unroll
        for (int sub = 0; sub < 4; ++sub)
#pragma unroll
          for (int j = 0; j < 4; ++j) mx = fmaxf(mx, s[r2][sub][j]);
        mx = xrow_max(mx);
        float mn = m[r2];
        if (__builtin_amdgcn_ballot_w64(mx - mn > 8.f) != 0ull) {
          mn = fmaxf(m[r2], mx);
          const float alpha = __builtin_amdgcn_exp2f(m[r2] - mn);
          m[r2] = mn; l[r2] *= alpha;
#pragma unroll
          for (int n = 0; n < 8; ++n) o[r2][n] *= alpha;
        }
        float ps = 0.f;
#pragma unroll
        for (int sub = 0; sub < 4; ++sub)
#pragma unroll
          for (int j = 0; j < 4; ++j) { s[r2][sub][j] = __builtin_amdgcn_exp2f(s[r2][sub][j] - mn); ps += s[r2][sub][j]; }
        l[r2] += ps;
#pragma unroll
        for (int kg = 0; kg < 2; ++kg) {
          pk[r2][kg].x = cvt_pk_bf16(s[r2][2 * kg][0], s[r2][2 * kg][1]); pk[r2][kg].y = cvt_pk_bf16(s[r2][2 * kg][2], s[r2][2 * kg][3]);
          pk[r2][kg].z = cvt_pk_bf16(s[r2][2 * kg + 1][0], s[r2][2 * kg + 1][1]); pk[r2][kg].w = cvt_pk_bf16(s[r2][2 * kg + 1][2], s[r2][2 * kg + 1][3]);
        }
      }
#pragma unroll
      for (int kg = 0; kg < 2; ++kg) {
        const bf16x8 pb0 = __builtin_bit_cast(bf16x8, pk[0][kg]), pb1 = __builtin_bit_cast(bf16x8, pk[1][kg]);
#pragma unroll
        for (int n = 0; n < 8; ++n) {
          const unsigned char* vp = vb + (n * 16 + fr) * AT_VROW + (kg * 32 + fq * 4) * 2;
          u32x2 v0 = *(const u32x2*)vp, v1 = *(const u32x2*)(vp + 32);
          const bf16x8 va = __builtin_bit_cast(bf16x8, ((u32x4){v0.x, v0.y, v1.x, v1.y}));
          o[0][n] = __builtin_amdgcn_mfma_f32_16x16x32_bf16(va, pb0, o[0][n], 0, 0, 0);
          o[1][n] = __builtin_amdgcn_mfma_f32_16x16x32_bf16(va, pb1, o[1][n], 0, 0, 0);
        }
      }
    }
    if (kt + 1 < ntiles) st_tile((kt + 1) & 1);
    __syncthreads();
  }
#pragma unroll
  for (int r2 = 0; r2 < 2; ++r2) {
    float lt = xrow_sum(l[r2]);
    const float inv = 1.f / lt;
    bf16_t* yo = Y3 + (size_t)(wq0 + r2 * 16 + fr) * 3072 + 1024 + h * 128 + fq * 8;
#pragma unroll
    for (int n = 0; n < 8; n += 2) *(u32x4*)(yo + (n >> 1) * 32) = pack8(o[r2][n] * inv, o[r2][n + 1] * inv);
  }
}

__device__ void sg_item(const Params& P, int l, int n, int g, unsigned char* lds) {
  unsigned char* ws = P.ws;
  const bf16_t* VN = (const bf16_t*)(ws + A_VN); const bf16_t* U = (const bf16_t*)(ws + A_U); const bf16_t* WS = (const bf16_t*)(ws + WT_SG);
  bf16_t* Y3 = (bf16_t*)(ws + A_Y3);
  const float* sb = (const float*)P.in[33] + (size_t)l * 1024 + g * 128;
  bf16_t* vt = (bf16_t*)lds;
  const int tid = ltid(), w = tid >> 6, lane = tid & 63, fr = lane & 15, fq = lane >> 4;
  __syncthreads();
#pragma unroll
  for (int i = 0; i < 4; ++i) {
    const int c = tid + i * 512, s = c >> 4, c8 = (c & 15) * 8;
    u32x4 v = *(const u32x4*)(VN + (size_t)(n * 128 + s) * 1024 + g * 128 + c8);
    const unsigned vv[4] = {v.x, v.y, v.z, v.w};
#pragma unroll
    for (int e = 0; e < 4; ++e) { vt[(c8 + 2 * e) * 136 + s] = (bf16_t)(vv[e] & 0xffff); vt[(c8 + 2 * e + 1) * 136 + s] = (bf16_t)(vv[e] >> 16); }
  }
  __syncthreads();
  const int trow = w * 16 + fr;
  bf16x8 wf[4];
  const bf16_t* wp = WS + ((size_t)g * 128 + trow) * 128 + fq * 8;
#pragma unroll
  for (int kk = 0; kk < 4; ++kk) wf[kk] = *(const bf16x8*)(wp + kk * 32);
  const int tt = n * 128 + trow;
  const float bias = sb[trow];
#pragma unroll
  for (int nn = 0; nn < 8; ++nn) {
    f32x4 acc = {0.f, 0.f, 0.f, 0.f};
#pragma unroll
    for (int kk = 0; kk < 4; ++kk) {
      bf16x8 b = *(const bf16x8*)(vt + (nn * 16 + fr) * 136 + kk * 32 + fq * 8);
      acc = __builtin_amdgcn_mfma_f32_16x16x32_bf16(b, wf[kk], acc, 0, 0, 0);
    }
    const int cc = g * 128 + nn * 16 + fq * 4;
    f32x4 u = ld_bf4(U + (size_t)tt * 1024 + cc);
    st_bf4(Y3 + (size_t)tt * 3072 + 2048 + cc, u * (acc + bias));
  }
}

__device__ void phase_post(const Params& P, int l) {
  unsigned char* ws = P.ws;
  const float* Y = (const float*)(ws + A_YSC); const float* VG = (const float*)(ws + A_VG);
  const bf16_t* KH = (const bf16_t*)(ws + A_KH); const bf16_t* R = (const bf16_t*)(ws + A_R); const bf16_t* LG = (const bf16_t*)(ws + A_LG);
  bf16_t* Y3 = (bf16_t*)(ws + A_Y3);
  const float* rk = (const float*)P.in[16] + l * 1024; const float* lw = (const float*)P.in[17] + l * 1024; const float* lb = (const float*)P.in[18] + l * 1024;
  const int wave = ltid() >> 6, lane = ltid() & 63;
  for (int t = lbid() * 8 + wave; t < T; t += gridDim.x * 8) {
#pragma unroll
    for (int i = 0; i < 4; ++i) {
      const int c = i * 256 + lane * 4; const size_t o = (size_t)t * 1024 + c;
      auto ntb = [](const bf16_t* p) { const u32x2 u = __builtin_nontemporal_load((const u32x2*)p); return (f32x4){bf_lo(u.x), bf_hi(u.x), bf_lo(u.y), bf_hi(u.y)}; };
      f32x4 y = __builtin_nontemporal_load((const f32x4*)(Y + o)), v = __builtin_nontemporal_load((const f32x4*)(VG + o)), r = ntb(R + o), kh = ntb(KH + o), g = ntb(LG + o);
      f32x4 rkv = *(const f32x4*)(rk + c);
      float s1 = sum16(y[0] + y[1] + y[2] + y[3]); const float mean = s1 * (1.f / 64.f);
      f32x4 d = y - mean;
      float s2 = sum16(d[0] * d[0] + d[1] * d[1] + d[2] * d[2] + d[3] * d[3]); const float rstd = rsqrtf(s2 * (1.f / 64.f) + 64e-5f);
      float bs = sum16(r[0] * kh[0] * rkv[0] + r[1] * kh[1] * rkv[1] + r[2] * kh[2] * rkv[2] + r[3] * kh[3] * rkv[3]);
      f32x4 out = (d * rstd * *(const f32x4*)(lw + c) + *(const f32x4*)(lb + c) + bs * v) * g;
      st_bf4(Y3 + (size_t)t * 3072 + c, out);
    }
  }
}

__device__ void phase_conv(const Params& P, int l) {
  unsigned char* ws = P.ws;
  const bf16_t* UP = (const bf16_t*)(ws + A_UP); bf16_t* ACT = (bf16_t*)(ws + A_ACT);
  const float* cw = (const float*)P.in[39] + (size_t)l * 3 * 11264; const float* cb = (const float*)P.in[40] + (size_t)l * 11264;
  const int tid = ltid(), wave = tid >> 6, lane = tid & 63;
  constexpr int RC = 32, NCG = DFF / 256;
  const f32x4 z4 = {0.f, 0.f, 0.f, 0.f};
  for (int item = lbid() * 8 + wave; item < (T / RC) * NCG; item += gridDim.x * 8) {
    const int cg = item % NCG, t0 = (item / NCG) * RC;
    const int j = (cg * 64 + lane) * 4;
    const f32x4 wg0 = *(const f32x4*)(cw + j), wg1 = *(const f32x4*)(cw + 11264 + j), wg2 = *(const f32x4*)(cw + 2 * 11264 + j), bg = *(const f32x4*)(cb + j);
    const f32x4 wv0 = *(const f32x4*)(cw + DFF + j), wv1 = *(const f32x4*)(cw + 11264 + DFF + j), wv2 = *(const f32x4*)(cw + 2 * 11264 + DFF + j), bv = *(const f32x4*)(cb + DFF + j);
    const bf16_t* up = UP + (size_t)t0 * 11264 + j;
    f32x4 g1 = t0 >= 1 ? ld_bf4(up - 11264) : z4, g2 = t0 >= 2 ? ld_bf4(up - 2 * 11264) : z4;
    f32x4 v1 = t0 >= 1 ? ld_bf4(up - 11264 + DFF) : z4, v2 = t0 >= 2 ? ld_bf4(up - 2 * 11264 + DFF) : z4;
    bf16_t* ao = ACT + (size_t)t0 * DFF + j;
#pragma unroll 8
    for (int t = 0; t < RC; ++t) {
      const u32x2 gr = __builtin_nontemporal_load((const u32x2*)(up + (size_t)t * 11264)), vr = __builtin_nontemporal_load((const u32x2*)(up + (size_t)t * 11264 + DFF));
      const f32x4 g0 = {bf_lo(gr.x), bf_hi(gr.x), bf_lo(gr.y), bf_hi(gr.y)}, v0 = {bf_lo(vr.x), bf_hi(vr.x), bf_lo(vr.y), bf_hi(vr.y)};
      const f32x4 cgv = bg + wg2 * g0 + wg1 * g1 + wg0 * g2;
      const f32x4 cvv = bv + wv2 * v0 + wv1 * v1 + wv0 * v2;
      f32x4 o;
#pragma unroll
      for (int e = 0; e < 4; ++e) o[e] = cgv[e] * sigmoidf_(cgv[e]) * cvv[e];
      st_bf4(ao + (size_t)t * DFF, o);
      g2 = g1; g1 = g0; v2 = v1; v1 = v0;
    }
  }
}

constexpr int NPL = 14, NPH = 1 + NL * NPL;
DEVI int phase_njobs(int pl, int l) {
  switch (pl) { case 1: return 1; case 3: return l > 0 ? 6 : 5; case 4: return l > 0 ? 1 : 0; case 6: return 1; case 8: return 1; case 9: return 1; case 11: return 1; case 13: return 1; default: return 0; }
}
DEVI GJob get_job(const Params& P, int pl, int l, int j) {
  unsigned char* ws = P.ws; GJob g{}; g.keep = 0;
  const float* mod = (const float*)(ws + WS_MOD) + l * 12288;
  switch (pl) {
    case 1: g.A = (const bf16_t*)(ws + A_H); g.lda = 2048; g.Bt = (const bf16_t*)(ws + WT_IN + (size_t)(l & 1) * WTIN_BYTES); g.ldb = 2048; g.N = PW; g.K = 2048; g.mode = 0; g.out = ws + A_P; g.ldo = PW; break;
    case 3:
      if (j == 0) { g.A = (const bf16_t*)(ws + A_QL); g.lda = 512; g.Bt = (const bf16_t*)(ws + WT_UQ); g.ldb = 512; g.N = 1536; g.K = 512; g.mode = 0; g.out = ws + A_QRAW; g.ldo = 1536; }
      else if (j == 1) { g.A = (const bf16_t*)(ws + A_CKV); g.lda = 512; g.Bt = (const bf16_t*)(ws + WT_UKV); g.ldb = 512; g.N = 2048; g.K = 512; g.mode = 0; g.out = ws + A_KVRAW; g.ldo = 2048; }
      else if (j == 2) { g.A = (const bf16_t*)(ws + A_AL); g.lda = 768; g.Bt = (const bf16_t*)(ws + WT_LW); g.ldb = 256; g.N = 1024; g.K = 256; g.mode = 1; g.out = ws + A_LW; g.ldo = 1024; }
      else if (j == 3) { g.A = (const bf16_t*)(ws + A_AL) + 256; g.lda = 768; g.Bt = (const bf16_t*)(ws + WT_LA); g.ldb = 256; g.N = 1024; g.K = 256; g.mode = 1; g.out = ws + A_LA; g.ldo = 1024; }
      else if (j == 4) { g.A = (const bf16_t*)(ws + A_AL) + 512; g.lda = 768; g.Bt = (const bf16_t*)(ws + WT_LG); g.ldb = 256; g.N = 1024; g.K = 256; g.mode = 0; g.out = ws + A_LG; g.ldo = 1024; }
      else { g.A = (const bf16_t*)(ws + A_VB); g.lda = 1024; g.Bt = (const bf16_t*)(ws + WT_V1); g.ldb = 1024; g.N = 256; g.K = 1024; g.mode = 0; g.out = ws + A_VL; g.ldo = 256; }
      break;
    case 4: g.A = (const bf16_t*)(ws + A_VL); g.lda = 256; g.Bt = (const bf16_t*)(ws + WT_V2); g.ldb = 256; g.N = 1024; g.K = 256; g.mode = 1; g.out = ws + A_VG; g.ldo = 1024; break;
    case 6: g.A = (const bf16_t*)(ws + A_H); g.lda = 2048; g.Bt = (const bf16_t*)(ws + WT_IN + (size_t)(l & 1) * WTIN_BYTES) + (size_t)PW * 2048; g.ldb = 2048; g.N = NGATE; g.K = 2048; g.mode = 2; g.out = ws + A_GATE; g.ldo = NGATE; break;
    case 8: g.A = (const bf16_t*)(ws + A_Y3); g.lda = 3072; g.Bt = (const bf16_t*)(ws + WT_BR); g.ldb = 3072; g.N = 2048; g.K = 3072; g.mode = 7;
            g.out = ws + A_MERG; g.aux = ws + A_GATE; g.ldo = 2048; break;
    case 9: g.A = (const bf16_t*)(ws + A_MERG); g.lda = 2048; g.Bt = (const bf16_t*)(ws + WT_OUT); g.ldb = 2048; g.N = 2048; g.K = 2048; g.mode = 6;
            g.out = ws + WS_X; g.aux = (l == 0) ? P.in[0] : (const void*)(ws + WS_X); g.aux2 = mod + 2 * 2048; g.ldo = 2048; break;
    case 11: g.A = (const bf16_t*)(ws + A_H); g.lda = 2048; g.Bt = (const bf16_t*)(ws + WT_UP); g.ldb = 2048; g.N = 11264; g.K = 2048; g.mode = 0; g.out = ws + A_UP; g.ldo = 11264; break;
    default: g.A = (const bf16_t*)(ws + A_ACT); g.lda = DFF; g.Bt = (const bf16_t*)(ws + WT_DN); g.ldb = DFF; g.N = 2048; g.K = DFF; g.mode = 6;
            g.out = (l == NL - 1) ? (void*)P.out : (void*)(ws + WS_X); g.aux = ws + WS_X; g.aux2 = mod + 5 * 2048; g.ldo = 2048; break;
  }
  g.A = (const bf16_t*)uptr(g.A); g.Bt = (const bf16_t*)uptr(g.Bt); g.out = (void*)uptr(g.out); g.aux = uptr(g.aux); g.aux2 = uptr(g.aux2);
  g.lda = __builtin_amdgcn_readfirstlane(g.lda); g.ldb = __builtin_amdgcn_readfirstlane(g.ldb); g.ldo = __builtin_amdgcn_readfirstlane(g.ldo);
  g.N = __builtin_amdgcn_readfirstlane(g.N); g.K = __builtin_amdgcn_readfirstlane(g.K); g.mode = __builtin_amdgcn_readfirstlane(g.mode); g.keep = __builtin_amdgcn_readfirstlane(g.keep);
  return g;
}

__global__ void __launch_bounds__(512) fwd_kernel(Params Parg) {
  extern __shared__ __attribute__((aligned(16))) unsigned char lds[];
  cg::grid_group grid = cg::this_grid();
  const int ph_lo = Parg.ph_lo, ph_hi = Parg.ph_hi;
  __shared__ uint4 xb_words;
  if (__builtin_amdgcn_workitem_id_x() == 0) xb_words = make_uint4(0u, 0u, 0u, 0u);
  __syncthreads();
  XcdBarrier xb = xcd_barrier_post((unsigned*)(Parg.ws + WS_BAR), (volatile LAS unsigned*)&xb_words);
  for (int ph = ph_lo; ph < ph_hi; ++ph) {
    const __attribute__((address_space(4))) Params* pp = (const __attribute__((address_space(4))) Params*)__builtin_amdgcn_kernarg_segment_ptr();
    asm volatile("" : "+s"(pp));
    const Params& P = *(const Params*)pp;
    unsigned char* ws = P.ws;
    int l = 0, pl = -1;
    if (ph > 0) { l = (ph - 1) / NPL; pl = (ph - 1) % NPL; }
    const float* mod = (const float*)(ws + WS_MOD) + l * 12288;
    const int nrep = ((ph > 0 && ((PROBE_MASK >> pl) & 1)) || (ph == 0 && ((PROBE_MASK >> 30) & 1))) ? 2 : 1;
    for (int rep = 0; rep < nrep; ++rep) {
    int c = lbid(), G = gridDim.x;
    if (ph == 0) { if (EN_INIT) phase_init(P, lds); }
    else switch (pl) {
      case 0: {
        const float* xin = (l == 0) ? (const float*)P.in[0] : (const float*)(ws + WS_X);
        if (EN_MISC) phase_h(xin, (const float*)P.in[5] + l * D, mod, mod + 2048, (bf16_t*)(ws + A_H));
      } break;
      case 2: if (EN_PREP) phase_prep1(P, l); break;
      case 5: if (EN_PREP) phase_prep2(P, l, lds); break;
      case 6: {
        if ((int)lbid() < NSCAN) { if (EN_SCAN && (rep == 0 || (PROBE_PART & 1))) scan_block(P, lbid(), lds); c = -1; }
        else {
          c = lbid() - NSCAN; G = gridDim.x - NSCAN;
          __syncthreads();
        }
      } break;
      case 7: if (EN_MISC) phase_post(P, l); break;
      case 10: if (EN_MISC) phase_h((const float*)(ws + WS_X), (const float*)P.in[6] + l * D, mod + 3 * 2048, mod + 4 * 2048, (bf16_t*)(ws + A_H)); break;
      case 12: if (EN_MISC) phase_conv(P, l); break;
      default: break;
    }
    {
      constexpr unsigned CM_IN = 0x1Fu, CM_SMALL = 0xFE0u, CM_LATE = 0x3F000u, CM_SG = 1u << 18;
      unsigned cm0 = 0, cm1 = 0; int cl1 = l + 1;
      int cc = c, cG = G;
      const int slot = (c & 7) * (G >> 3) + (c >> 3);
      if (ph == 0) cm0 = CM_IN | CM_SMALL | CM_SG;
      else if (pl == 1 && rep == 0) { cm0 = (1u << 15) | (1u << 16); cc = slot - 96; cG = 160; }
      else if (pl == 11 && l + 1 < NL && rep == 0) { cm1 = CM_IN | CM_SMALL | CM_SG; cc = slot - 128; cG = 128; }
      else if (pl == 6 && c >= 0 && (rep == 0 || (PROBE_PART & 16))) cm0 = (7u << 12) | (1u << 17);
      for (int k = 0; k < 2; ++k) { const unsigned m = k ? cm1 : cm0; if (m && EN_INIT && cc >= 0) convert_layer(P, k ? cl1 : l, m, cc, cG, lds); }
    }
    if (ph > 0) {
      const int nj = phase_njobs(pl, l);
      int cursor = 0;
      for (int j = 0; j < nj; ++j) { GJob jb = get_job(P, pl, l, j); if (EN_GEMM && (pl != 6 || rep == 0 || (PROBE_PART & 8))) gemm_job(jb, cursor, c, G, lds); }
    }
    if (ph > 0 && pl == 6 && c >= 0) {
      if (EN_ATTN && (rep == 0 || (PROBE_PART & 2))) {
        unsigned* qctr = (unsigned*)(ws + WS_BAR) + 3600 + (l * 2 + rep) * 64;
        volatile int* slot = (volatile int*)(lds + 131056);
        for (;;) {
          __syncthreads();
          if (ltid() == 0) *slot = (int)atomicAdd(qctr, 1u);
          __syncthreads();
          const int idx = *slot;
          if (idx >= 256) break;
          attn_block(P, idx & 7, 31 - (idx >> 3), lds);
        }
      }
      for (int it = c; it < 512; it += G) if (EN_SG && (rep == 0 || (PROBE_PART & 4))) sg_item(P, l, it >> 3, it & 7, lds);
      __syncthreads();
    }
    }
    if (ph_hi > 100000) grid.sync();
    if (ph + 1 < ph_hi && !(pl == 4 && l == 0)) xcd_barrier(xb);
  }
}

extern "C" void kernel_launch(void* const* d_in, const int* in_sizes, int n_in, void* d_out, int out_size, void* d_ws, size_t ws_size, hipStream_t stream) {
  static int grid = 0;
  if (grid == 0) {
    if (n_in != 42 || ws_size < WS_END) { fprintf(stderr, "kernel_launch: unexpected n_in %d / ws %zu (need %zu)\n", n_in, ws_size, (size_t)WS_END); grid = -1; return; }
    int dev = 0, cus = 0, per_cu = 0;
    hipGetDevice(&dev);
    hipDeviceGetAttribute(&cus, hipDeviceAttributeMultiprocessorCount, dev);
    if (hipFuncSetAttribute((const void*)fwd_kernel, hipFuncAttributeMaxDynamicSharedMemorySize, LDS_BYTES) != hipSuccess) { fprintf(stderr, "kernel_launch: hipFuncSetAttribute failed\n"); grid = -1; return; }
    hipOccupancyMaxActiveBlocksPerMultiprocessor(&per_cu, (const void*)fwd_kernel, 512, LDS_BYTES);
    if (per_cu < 1) { fprintf(stderr, "kernel_launch: occupancy query returned %d\n", per_cu); per_cu = 1; }
    (void)hipGetLastError();
    grid = cus;
  }
  if (grid < 0) return;
  Params p{};
  for (int i = 0; i < 42; ++i) p.in[i] = d_in[i];
  p.out = (float*)d_out; p.ws = (unsigned char*)d_ws;
  if (hipMemsetAsync((char*)d_ws + WS_MOD, 0, WS_BAR + 16384 - WS_MOD, stream) != hipSuccess)
#if N_LAUNCH_MODE == 1
  p.ph_lo = 0; p.ph_hi = NPH;
  void* args[] = {&p};
  hipError_t e = hipLaunchCooperativeKernel((const void*)fwd_kernel, dim3(grid), dim3(512), args, LDS_BYTES, stream);
  if (e != hipSuccess) fprintf(stderr, "cooperative launch failed: %s (grid %d)\n", hipGetErrorString(e), grid);
#else
  for (int ph = 0; ph < NPH; ++ph) {
    p.ph_lo = ph; p.ph_hi = ph + 1;
    hipLaunchKernelGGL(fwd_kernel, dim3(grid), dim3(512), LDS_BYTES, stream, p);
  }
#endif
}
```

```cpp
#include <hip/hip_runtime.h>
#include <hip/hip_cooperative_groups.h>
#include <cstdio>
namespace cg = cooperative_groups;

#ifndef EN_MISC
#define EN_MISC 1
#endif
#ifndef EN_INIT
#define EN_INIT 1
#endif
#ifndef EN_PREP
#define EN_PREP 1
#endif
#ifndef EN_SCAN
#define EN_SCAN 1
#endif
#ifndef EN_ATTN
#define EN_ATTN 1
#endif
#ifndef EN_SG
#define EN_SG 1
#endif
#ifndef EN_GEMM
#define EN_GEMM 1
#endif
#ifndef PROBE_MASK
#define PROBE_MASK 0
#endif
#ifndef PROBE_PART
#define PROBE_PART 0
#endif
#ifndef N_LAUNCH_MODE
#define N_LAUNCH_MODE 1
#endif

typedef unsigned short bf16_t;
typedef short bf16x8 __attribute__((ext_vector_type(8)));
typedef float f32x4 __attribute__((ext_vector_type(4)));
typedef float f32x2 __attribute__((ext_vector_type(2)));
typedef unsigned u32x4 __attribute__((ext_vector_type(4)));
typedef unsigned u32x2 __attribute__((ext_vector_type(2)));
#define DEVI __device__ __forceinline__

constexpr int T = 8192, D = 2048, NL = 2;
constexpr int NIN = 12800;
constexpr int PW = 6912;
constexpr int PC_DQ = 3584, PC_CKV = 4096, PC_KR = 4608, PC_U = 4864, PC_VS = 5888;
constexpr int NGATE = 6144;
constexpr int DFF = 5632;
constexpr int NSCAN = 64;

constexpr size_t al256(size_t x) { return (x + 255) & ~(size_t)255; }
constexpr size_t WS_MOD = 0;
constexpr size_t WS_BAR = al256(WS_MOD + (size_t)NL * 6 * D * 4);
constexpr size_t WS_COS = WS_BAR + 16384;
constexpr size_t WS_SIN = WS_COS + (size_t)T * 32 * 4;
constexpr size_t WS_X   = WS_SIN + (size_t)T * 32 * 4;
constexpr size_t WS_VF  = WS_X + (size_t)T * D * 4;
constexpr size_t WT_IN  = WS_VF + (size_t)T * 1024 * 4;
constexpr size_t WTIN_BYTES = (size_t)13056 * 2048 * 2;
constexpr size_t WT_UQ  = WT_IN + 2 * WTIN_BYTES;
constexpr size_t WT_UKV = WT_UQ + (size_t)1536 * 512 * 2;
constexpr size_t WT_LW  = WT_UKV + (size_t)2048 * 512 * 2;
constexpr size_t WT_LA  = WT_LW + (size_t)1024 * 256 * 2;
constexpr size_t WT_LG  = WT_LA + (size_t)1024 * 256 * 2;
constexpr size_t WT_V1  = WT_LG + (size_t)1024 * 256 * 2;
constexpr size_t WT_V2  = WT_V1 + (size_t)256 * 1024 * 2;
constexpr size_t WT_BR  = WT_V2 + (size_t)1024 * 256 * 2;
constexpr size_t WT_OUT = WT_BR + (size_t)3 * 2048 * 1024 * 2;
constexpr size_t WT_UP  = WT_OUT + (size_t)2048 * 2048 * 2;
constexpr size_t WT_DN  = WT_UP + (size_t)11264 * 2048 * 2;
constexpr size_t WT_SG  = WT_DN + (size_t)2048 * 5632 * 2;
constexpr size_t A_H    = WT_SG + (size_t)8 * 128 * 128 * 2;
constexpr size_t A_P    = A_H + (size_t)T * 2048 * 2;
constexpr size_t A_GATE = A_P;
constexpr size_t A_LW   = A_P + (size_t)T * PW * 2;
constexpr size_t A_LA   = A_LW + (size_t)T * 1024 * 4;
constexpr size_t A_VG   = A_LA + (size_t)T * 1024 * 4;
constexpr size_t A_MACC = A_LW;
constexpr size_t A_MERG = A_VG;
constexpr size_t A_LG   = A_VG + (size_t)T * 1024 * 4;
constexpr size_t A_VL   = A_LG + (size_t)T * 1024 * 2;
constexpr size_t A_QRAW = A_VL + (size_t)T * 256 * 2;
constexpr size_t A_KVRAW= A_QRAW + (size_t)T * 1536 * 2;
constexpr size_t A_AL   = A_KVRAW + (size_t)T * 2048 * 2;
constexpr size_t A_VB   = A_AL + (size_t)T * 768 * 2;
constexpr size_t A_YSC  = A_QRAW;
constexpr size_t A_Y3   = A_YSC + (size_t)T * 1024 * 4;
constexpr size_t A_QL   = A_VB + (size_t)T * 1024 * 2;
constexpr size_t A_CKV  = A_QL + (size_t)T * 512 * 2;
constexpr size_t A_KR   = A_CKV + (size_t)T * 512 * 2;
constexpr size_t A_U    = A_KR + (size_t)T * 64 * 2;
constexpr size_t A_VN   = A_U + (size_t)T * 1024 * 2;
constexpr size_t A_KK   = A_VN + (size_t)T * 1024 * 2;
constexpr size_t A_KH   = A_KK + (size_t)T * 1024 * 4;
constexpr size_t A_R    = A_KH + (size_t)T * 1024 * 2;
constexpr size_t A_Q    = A_R + (size_t)T * 1024 * 2;
constexpr size_t A_K    = A_Q + (size_t)8 * T * 192 * 2;
constexpr size_t A_VT   = A_K + (size_t)8 * T * 192 * 2;
constexpr size_t WS_END = A_VT + (size_t)8 * 128 * T * 2;
constexpr size_t A_UP   = A_P;
constexpr size_t A_ACT  = A_UP + (size_t)T * 11264 * 2;
static_assert(A_Y3 + (size_t)T * 3072 * 2 <= A_QL, "alias overflow");
static_assert(A_ACT + (size_t)T * DFF * 2 <= WS_END, "ffn alias overflow");
static_assert(WS_END < 858000000ull, "workspace too large");

constexpr int LDS_BYTES = 131072;

struct Params {
  const void* in[42];
  float* out;
  unsigned char* ws;
  int ph_lo, ph_hi;
};

DEVI int lbid() { int t = __builtin_amdgcn_workgroup_id_x(); asm volatile("" : "+s"(t)); return t; }
DEVI const void* uptr(const void* p) { unsigned long long v = (unsigned long long)p; unsigned lo = __builtin_amdgcn_readfirstlane((unsigned)v), hi = __builtin_amdgcn_readfirstlane((unsigned)(v >> 32)); return (const void*)(((unsigned long long)hi << 32) | lo); }
DEVI int ltid() { int t = __builtin_amdgcn_workitem_id_x(); asm volatile("" : "+v"(t)); return t; }
DEVI unsigned cvt_pk_bf16(float lo, float hi) { unsigned r; asm("v_cvt_pk_bf16_f32 %0, %1, %2" : "=v"(r) : "v"(lo), "v"(hi)); return r; }
DEVI float bf_lo(unsigned u) { return __uint_as_float(u << 16); }
DEVI float bf_hi(unsigned u) { return __uint_as_float(u & 0xffff0000u); }
DEVI float bf2f(bf16_t h) { return __uint_as_float(((unsigned)h) << 16); }
DEVI bf16_t f2bf(float f) { return (bf16_t)(cvt_pk_bf16(f, 0.f) & 0xffffu); }
DEVI float sigmoidf_(float x) { return 1.f / (1.f + __expf(-x)); }
DEVI float tanhf_(float x) { x = fminf(fmaxf(x, -15.f), 15.f); float t = __expf(2.f * x); return (t - 1.f) / (t + 1.f); }
DEVI float geluf_(float x) { return 0.5f * x * (1.f + tanhf_(0.7978845608028654f * (x + 0.044715f * x * x * x))); }
DEVI float wave_sum(float v) {
#pragma unroll
  for (int o = 32; o > 0; o >>= 1) v += __shfl_xor(v, o);
  return v;
}
DEVI float sum16(float v) {
#pragma unroll
  for (int o = 8; o > 0; o >>= 1) v += __shfl_xor(v, o);
  return v;
}
DEVI float dpp_allreduce16(float x) {
  x += __builtin_bit_cast(float, __builtin_amdgcn_update_dpp(0, __builtin_bit_cast(int, x), 0xB1, 0xF, 0xF, true));
  x += __builtin_bit_cast(float, __builtin_amdgcn_update_dpp(0, __builtin_bit_cast(int, x), 0x4E, 0xF, 0xF, true));
  x += __builtin_bit_cast(float, __builtin_amdgcn_update_dpp(0, __builtin_bit_cast(int, x), 0x141, 0xF, 0xF, true));
  x += __builtin_bit_cast(float, __builtin_amdgcn_update_dpp(0, __builtin_bit_cast(int, x), 0x140, 0xF, 0xF, true));
  return x;
}
DEVI float xrow_max(float x) {
  auto a = __builtin_amdgcn_permlane16_swap(__float_as_uint(x), __float_as_uint(x), false, false);
  float m1 = fmaxf(__uint_as_float(a[0]), __uint_as_float(a[1]));
  auto b = __builtin_amdgcn_permlane32_swap(__float_as_uint(m1), __float_as_uint(m1), false, false);
  return fmaxf(__uint_as_float(b[0]), __uint_as_float(b[1]));
}
DEVI float xrow_sum(float x) {
  auto a = __builtin_amdgcn_permlane16_swap(__float_as_uint(x), __float_as_uint(x), false, false);
  float m1 = __uint_as_float(a[0]) + __uint_as_float(a[1]);
  auto b = __builtin_amdgcn_permlane32_swap(__float_as_uint(m1), __float_as_uint(m1), false, false);
  return __uint_as_float(b[0]) + __uint_as_float(b[1]);
}
DEVI f32x4 ld_bf4(const bf16_t* p) { u32x2 u = *(const u32x2*)p; return (f32x4){bf_lo(u.x), bf_hi(u.x), bf_lo(u.y), bf_hi(u.y)}; }
DEVI void st_bf4(bf16_t* p, f32x4 v) { u32x2 u; u.x = cvt_pk_bf16(v[0], v[1]); u.y = cvt_pk_bf16(v[2], v[3]); *(u32x2*)p = u; }


#define XB_TMO      128
#define XB_XCNT(j)  (256  + 64 * (j))
#define XB_XSUB(j)  (1280 + 64 * (j))
#define XB_XGEN(j)  (2304 + 64 * (j))
#define XB_TOP      3328
#define XB_TOPGEN   3392
#define XCD_BAR_WORDS 3456
#define XB_SPIN_CAP (1u << 20)
#define LAS __attribute__((address_space(3)))
DEVI unsigned xb_ld(unsigned* p) { return __hip_atomic_load(p, __ATOMIC_RELAXED, __HIP_MEMORY_SCOPE_AGENT); }
DEVI unsigned xb_add(unsigned* p, unsigned v) { return __hip_atomic_fetch_add(p, v, __ATOMIC_RELAXED, __HIP_MEMORY_SCOPE_AGENT); }
DEVI unsigned xb_xcc_id() { return (unsigned)__builtin_amdgcn_s_getreg((3 << 11) | 20) & 0xFu; }
#define XB_SPIN(cond, bar) do { unsigned _sp = 0; while (cond) { __builtin_amdgcn_s_sleep(4); \
    if ((++_sp & 255u) == 0u) { if (xb_ld(&(bar)[XB_TMO])) break; if (_sp > XB_SPIN_CAP) { atomicAdd(&(bar)[XB_TMO], 1u); break; } } } } while (0)
struct XcdBarrier { unsigned* bar; unsigned x; volatile LAS unsigned* st; };
DEVI XcdBarrier xcd_barrier_post(unsigned* bar, volatile LAS unsigned* st) {
  XcdBarrier b; b.bar = bar; b.x = xb_xcc_id(); b.st = st;
  if (__builtin_amdgcn_workitem_id_x() == 0) (void)xb_add(&bar[XB_XCNT(b.x)], 1u);
  return b;
}
DEVI void xcd_barrier_complete(unsigned* bar, unsigned x, unsigned& nloc, unsigned& nx) {
  const unsigned G = gridDim.x;
  unsigned sum, cnt, mine, sp = 0u;
  for (;;) {
    sum = 0u; cnt = 0u; mine = 0u;
#pragma unroll
    for (unsigned j = 0; j < 16; ++j) { const unsigned c = xb_ld(&bar[XB_XCNT(j)]); sum += c; cnt += (c > 0u) ? 1u : 0u; mine = (j == x) ? c : mine; }
    if (sum == G) break;
    __builtin_amdgcn_s_sleep(1);
    if ((++sp & 255u) == 0u) { if (xb_ld(&bar[XB_TMO])) break; if (sp > XB_SPIN_CAP) { atomicAdd(&bar[XB_TMO], 1u); break; } }
  }
  nloc = mine > 0u ? mine : 1u; nx = cnt > 0u ? cnt : 1u;
}
DEVI void xcd_barrier(const XcdBarrier& b) {
  asm volatile("s_waitcnt vmcnt(0)" ::: "memory");
  __syncthreads();
  if (__builtin_amdgcn_workitem_id_x() == 0) {
    unsigned* bar = b.bar;
    __builtin_amdgcn_s_waitcnt(0);
    unsigned nloc = b.st[0], nx = b.st[1];
    if (nloc == 0u) { xcd_barrier_complete(bar, b.x, nloc, nx); b.st[0] = nloc; b.st[1] = nx; }
    const unsigned old = xb_add(&bar[XB_XSUB(b.x)], 1u);
    const unsigned gen = old / nloc;
    if (old + 1u == (gen + 1u) * nloc) {
      __builtin_amdgcn_fence(__ATOMIC_RELEASE, "agent");
      asm volatile("s_waitcnt vmcnt(0)" ::: "memory");
      const unsigned og = xb_add(&bar[XB_TOP], 1u);
      const unsigned tg = og / nx;
      if (og + 1u == (tg + 1u) * nx) xb_add(&bar[XB_TOPGEN], 1u);
      else XB_SPIN(xb_ld(&bar[XB_TOPGEN]) == tg, bar);
      __builtin_amdgcn_fence(__ATOMIC_ACQUIRE, "agent");
      xb_add(&bar[XB_XGEN(b.x)], 1u);
      asm volatile("s_waitcnt vmcnt(0)" ::: "memory");
    } else {
      XB_SPIN(xb_ld(&bar[XB_XGEN(b.x)]) == gen, bar);
      __builtin_amdgcn_fence(__ATOMIC_ACQUIRE, "agent");
      asm volatile("s_waitcnt vmcnt(0)" ::: "memory");
    }
  }
  __syncthreads();
}

constexpr int BM = 256, BK = 64, HALF = 128, HT = HALF * BK, WGM = 8;
struct GJob { const bf16_t* A; const bf16_t* Bt; void* out; const void* aux; const void* aux2; int lda, ldb, ldo, N, K, mode, keep; };

DEVI int lds_byte(int r, int c) { int st = (r >> 4) * 2 + (c >> 5), rr = r & 15, cc = c & 31, ob = rr * 64 + cc * 2; return st * 1024 + (ob ^ (((ob >> 9) & 1) << 5)); }
DEVI void stage_rc(int b, int& R, int& C) { int st = b >> 10, sb = b & 1023, swz = sb ^ (((sb >> 9) & 1) << 5); R = (st >> 1) * 16 + (swz >> 6); C = (st & 1) * 32 + ((swz & 63) >> 1); }

DEVI int perm32(int rho) { const int n = rho >> 4, i = rho & 15; return 8 * (i >> 2) + 4 * n + (i & 3); }
DEVI u32x4 pack8(f32x4 a, f32x4 b) { u32x4 o; o.x = cvt_pk_bf16(a[0], a[1]); o.y = cvt_pk_bf16(a[2], a[3]); o.z = cvt_pk_bf16(b[0], b[1]); o.w = cvt_pk_bf16(b[2], b[3]); return o; }
DEVI void gemm_epi(const GJob& jb, int row, int col, f32x4 v0, f32x4 v1) {
  const int mode = jb.mode;
  if (mode == 0) { *(u32x4*)((bf16_t*)jb.out + (size_t)row * jb.ldo + col) = pack8(v0, v1); }
  else if (mode == 1) { float* p = (float*)jb.out + (size_t)row * jb.ldo + col; *(f32x4*)p = v0; *(f32x4*)(p + 4) = v1; }
  else if (mode == 2) { f32x4 s0, s1; for (int i = 0; i < 4; ++i) { s0[i] = sigmoidf_(v0[i]); s1[i] = sigmoidf_(v1[i]); } *(u32x4*)((bf16_t*)jb.out + (size_t)row * jb.ldo + col) = pack8(s0, s1); }
  else if (mode == 7) {
    const u32x4 g = *(const u32x4*)((const bf16_t*)jb.aux + (size_t)row * NGATE + 2 * 2048 + col);
    const f32x4 g0 = {bf_lo(g.x), bf_hi(g.x), bf_lo(g.y), bf_hi(g.y)}, g1 = {bf_lo(g.z), bf_hi(g.z), bf_lo(g.w), bf_hi(g.w)};
    *(u32x4*)((bf16_t*)jb.out + (size_t)row * 2048 + col) = pack8(g0 * v0, g1 * v1);
  } else {
    const float* xp = (const float*)jb.aux + (size_t)row * jb.ldo + col; const float* gp = (const float*)jb.aux2 + col;
    float* op = (float*)jb.out + (size_t)row * jb.ldo + col;
    const f32x4 x0 = *(const f32x4*)xp, x1 = *(const f32x4*)(xp + 4), t0 = *(const f32x4*)gp, t1 = *(const f32x4*)(gp + 4);
    *(f32x4*)op = x0 + t0 * v0; *(f32x4*)(op + 4) = x1 + t1 * v1;
  }
}

DEVI void gemm_tile(const GJob& jb, int brow, int bcol, unsigned char* shm_) {
  LAS unsigned char* lds = (LAS unsigned char*)shm_;
  const int lda = jb.lda, ldb = jb.ldb, K = jb.K;
  const int tid = ltid(), wid = __builtin_amdgcn_readfirstlane(tid >> 6), lane = tid & 63, wr = wid >> 2, wc = wid & 3, fr = lane & 15, fq = lane >> 4;
  unsigned voffA[2], voffB[2];
#pragma unroll
  for (int i = 0; i < 2; ++i) { int R, C; stage_rc(tid * 16 + i * 8192, R, C); const int Rb = (R & ~31) + perm32(R & 31); voffA[i] = (unsigned)(R * lda + C) * 2u; voffB[i] = (unsigned)(Rb * ldb + C) * 2u; }
  const size_t hA = (size_t)HALF * lda * 2, hB = (size_t)HALF * ldb * 2;
  const unsigned ldsw = (unsigned)wid * 1024u;
  const int aoff = lds_byte(wr * 64 + fr, fq * 8), boff = lds_byte(wc * 32 + fr, fq * 8);
  constexpr int HTB = HT * 2;
#define SA(b,h) (((b)*2+(h))*HTB)
#define SB(b,h) ((4+(b)*2+(h))*HTB)
#define STAGE(bufoff,gbase,voff) do{ _Pragma("unroll") for(int _i=0;_i<2;++_i) \
    __builtin_amdgcn_global_load_lds((const unsigned*)((const char*)(gbase)+(voff)[_i]),(LAS unsigned*)(lds+(bufoff)+ldsw+_i*8192),16,0,0);}while(0)
#define LDA(dst,b,h) do{ _Pragma("unroll") for(int m=0;m<4;++m) _Pragma("unroll") for(int k=0;k<2;++k) dst[m][k]=*(const LAS bf16x8*)(lds+SA(b,h)+aoff+m*2048+k*1024);}while(0)
#define LDB(dst,b,h) do{ _Pragma("unroll") for(int n=0;n<2;++n) _Pragma("unroll") for(int k=0;k<2;++k) dst[n][k]=*(const LAS bf16x8*)(lds+SB(b,h)+boff+n*2048+k*1024);}while(0)
#define MMA(ai,bj,At_,Bt_) do{__builtin_amdgcn_s_setprio(1); \
    _Pragma("unroll") for(int m=0;m<4;++m) _Pragma("unroll") for(int n=0;n<2;++n) _Pragma("unroll") for(int k=0;k<2;++k) \
      acc[ai][bj][m][n]=__builtin_amdgcn_mfma_f32_16x16x32_bf16(Bt_[n][k],At_[m][k],acc[ai][bj][m][n],0,0,0); \
    __builtin_amdgcn_s_setprio(0);}while(0)
#define WAIT_V(n) asm volatile("s_waitcnt vmcnt(" #n ")":::"memory")
#define WAIT_L(n) asm volatile("s_waitcnt lgkmcnt(" #n ")":::"memory")
#define BAR __builtin_amdgcn_s_barrier()
#define SCHED __builtin_amdgcn_sched_barrier(0)
  f32x4 acc[2][2][4][2];
#pragma unroll
  for (int a = 0; a < 2; ++a)
#pragma unroll
    for (int b = 0; b < 2; ++b)
#pragma unroll
      for (int m = 0; m < 4; ++m)
#pragma unroll
        for (int n = 0; n < 2; ++n) acc[a][b][m][n] = (f32x4){0.f, 0.f, 0.f, 0.f};
  bf16x8 At[4][2], B0[2][2], B1[2][2];
  const int nt = K / BK;
  const char* cA = (const char*)jb.A + (size_t)brow * lda * 2; const char* cB = (const char*)jb.Bt + (size_t)bcol * ldb * 2;
  STAGE(SB(0,0),cB,voffB); STAGE(SA(0,0),cA,voffA);
  STAGE(SB(0,1),cB+hB,voffB); STAGE(SA(0,1),cA+hA,voffA);
  if (wr == 1) BAR;
  WAIT_V(4); BAR;
  STAGE(SB(1,0),cB+128,voffB); STAGE(SA(1,0),cA+128,voffA); STAGE(SB(1,1),cB+hB+128,voffB);
  WAIT_V(6); BAR;
  for (int t = 0; t < nt - 2; t += 2) {
    if (jb.mode == 7 && (t == 16 || t == 32)) {
      const int seg = (t >> 4) - 1;
      const bf16_t* gp = (const bf16_t*)jb.aux + (size_t)(brow + wr * 64 + fr) * NGATE + seg * 2048 + bcol + wc * 32 + fq * 8;
#pragma unroll
      for (int ai = 0; ai < 2; ++ai)
#pragma unroll
        for (int m = 0; m < 4; ++m)
#pragma unroll
          for (int bj = 0; bj < 2; ++bj)
#pragma unroll
            for (int n = 0; n < 2; ++n) {
              const bf16_t* g = gp + (size_t)(ai * HALF + m * 16) * NGATE + bj * HALF + n * 4;
              const f32x4 g0 = ld_bf4(g), g1 = ld_bf4(g + 2048);
#pragma unroll
              for (int e = 0; e < 4; ++e) acc[ai][bj][m][n][e] *= g0[e] * __builtin_amdgcn_rcpf(fmaxf(g1[e], 1e-30f));
            }
    }
    const char* a1 = cA + (size_t)(t + 1) * 128; const char* a2 = a1 + 128; const char* a3 = a2 + 128;
    const char* b2 = cB + (size_t)(t + 2) * 128; const char* b3 = b2 + 128;
    LDB(B0,0,0); SCHED; LDA(At,0,0); STAGE(SA(1,1),a1+hA,voffA);
    WAIT_L(8); BAR; WAIT_L(0); MMA(0,0,At,B0); BAR; SCHED;
    LDB(B1,0,1); STAGE(SB(0,0),b2,voffB);
    BAR; WAIT_L(0); MMA(0,1,At,B1); BAR;
    LDA(At,0,1); STAGE(SA(0,0),a2,voffA);
    BAR; WAIT_L(0); MMA(1,0,At,B0); BAR; SCHED;
    STAGE(SB(0,1),b2+hB,voffB);
    WAIT_V(6); BAR; MMA(1,1,At,B1); BAR;
    LDB(B0,1,0); SCHED; LDA(At,1,0); STAGE(SA(0,1),a2+hA,voffA);
    WAIT_L(8); BAR; WAIT_L(0); MMA(0,0,At,B0); BAR; SCHED;
    LDB(B1,1,1); STAGE(SB(1,0),b3,voffB);
    BAR; WAIT_L(0); MMA(0,1,At,B1); BAR;
    LDA(At,1,1); STAGE(SA(1,0),a3,voffA);
    BAR; WAIT_L(0); MMA(1,0,At,B0); BAR; SCHED;
    STAGE(SB(1,1),b3+hB,voffB);
    WAIT_V(6); BAR; MMA(1,1,At,B1); BAR;
  }
  { LDB(B0,0,0); LDA(At,0,0); STAGE(SA(1,1),cA+(size_t)(nt-1)*128+hA,voffA);
    BAR; WAIT_L(0); MMA(0,0,At,B0); BAR;
    LDB(B1,0,1); BAR; WAIT_L(0); MMA(0,1,At,B1); BAR;
    LDA(At,0,1); WAIT_V(4); BAR; WAIT_L(0); MMA(1,0,At,B0); MMA(1,1,At,B1); BAR; }
  { LDB(B0,1,0); LDA(At,1,0); WAIT_V(2); BAR; WAIT_L(0); MMA(0,0,At,B0); BAR;
    LDB(B1,1,1); WAIT_V(0); BAR; WAIT_L(0); MMA(0,1,At,B1); BAR;
    LDA(At,1,1); BAR; WAIT_L(0); MMA(1,0,At,B0); MMA(1,1,At,B1); BAR; }
  if (wr == 0) BAR;
#pragma unroll
  for (int ai = 0; ai < 2; ++ai)
#pragma unroll
    for (int m = 0; m < 4; ++m)
#pragma unroll
      for (int bj = 0; bj < 2; ++bj)
        gemm_epi(jb, brow + ai * HALF + wr * 64 + m * 16 + fr, bcol + bj * HALF + wc * 32 + fq * 8, acc[ai][bj][m][0], acc[ai][bj][m][1]);
  __syncthreads();
#undef SA
#undef SB
#undef STAGE
#undef LDA
#undef LDB
#undef MMA
}

DEVI void gemm_job(const GJob& jb, int& cursor, int c, int G, unsigned char* lds) {
  const int nM = T / BM, nN = jb.N / BM, ntile = nM * nN;
  if (c >= 0) {
    const int slot = ((G & 7) == 0) ? (c & 7) * (G >> 3) + (c >> 3) : c;
    int first = (slot - cursor % G + G) % G;
    for (int i = first; i < ntile; i += G) {
      const int nig = WGM * nN, gid = i / nig, fm = gid * WGM, gsz = (nM - fm) < WGM ? (nM - fm) : WGM;
      const int pm = fm + ((i % nig) % gsz), pn = (i % nig) / gsz;
      gemm_tile(jb, pm * BM, pn * BM, lds);
    }
  }
  if (!jb.keep) cursor += ntile;
}

DEVI void convT(const float* __restrict__ src, int src_ld, int k_real, int n_real, bf16_t* __restrict__ dst, int dld, int k_pad, int n_pad, int& cursor, int c, int G, unsigned char* lds) {
  float* tile = (float*)lds;
  const int tk = k_pad / 128, tn = n_pad / 128, nt = tk * tn, tid = ltid(), w = tid >> 6, lane = tid & 63;
  int first = (c - cursor % G + G) % G;
  for (int i = first; i < nt; i += G) {
    const int n0 = (i / tk) * 128, k0 = (i % tk) * 128;
    { const int n = n0 + lane * 2; const bool nok = n < n_real;
      f32x2 v[16];
#pragma unroll
      for (int r = 0; r < 16; ++r) {
        const int k = k0 + w * 16 + r;
        v[r] = (f32x2){0.f, 0.f};
        if (nok && k < k_real) v[r] = __builtin_nontemporal_load((const f32x2*)(src + (size_t)k * src_ld + n));
      }
#pragma unroll
      for (int r = 0; r < 16; ++r) *(f32x2*)(tile + (w * 16 + r) * 130 + lane * 2) = v[r]; }
    __syncthreads();
    { const int n = tid >> 2, q = tid & 3;
#pragma unroll
      for (int jj = 0; jj < 4; ++jj) {
        const int k8 = (jj * 4 + q) * 8;
        const float* tp = tile + k8 * 130 + n;
        u32x4 o; o.x = cvt_pk_bf16(tp[0], tp[130]); o.y = cvt_pk_bf16(tp[260], tp[390]); o.z = cvt_pk_bf16(tp[520], tp[650]); o.w = cvt_pk_bf16(tp[780], tp[910]);
        *(u32x4*)(dst + (size_t)(n0 + n) * dld + k0 + k8) = o;
      } }
    __syncthreads();
  }
  cursor += nt;
}

__device__ void convert_layer(const Params& P, int l, unsigned mask, int c, int G, unsigned char* lds) {
  unsigned char* ws = P.ws;
  int cur = 0;
  for (int j = 0; j < 18; ++j) {
    if (!((mask >> j) & 1u)) continue;
    const float* src = nullptr; bf16_t* dst = nullptr; int sld = 0, kr = 0, nr = 0, kp = 0, np = 0;
    const float* w_in = (const float*)P.in[7] + (size_t)l * D * NIN;
    bf16_t* wtin = (bf16_t*)(ws + WT_IN + (size_t)(l & 1) * WTIN_BYTES);
    switch (j) {
      case 0: src = w_in; sld = NIN; kr = 2048; nr = 3520; dst = wtin; kp = 2048; np = 3584; break;
      case 1: src = w_in + 3520; sld = NIN; kr = 2048; nr = 512; dst = wtin + (size_t)3584 * 2048; kp = 2048; np = 512; break;
      case 2: src = w_in + 4032; sld = NIN; kr = 2048; nr = 576; dst = wtin + (size_t)4096 * 2048; kp = 2048; np = 768; break;
      case 3: src = w_in + 4608; sld = NIN; kr = 2048; nr = 2048; dst = wtin + (size_t)4864 * 2048; kp = 2048; np = 2048; break;
      case 4: src = w_in + 6656; sld = NIN; kr = 2048; nr = 6144; dst = wtin + (size_t)6912 * 2048; kp = 2048; np = 6144; break;
      case 5: src = (const float*)P.in[24] + (size_t)l * 512 * 1536; sld = 1536; kr = 512; nr = 1536; dst = (bf16_t*)(ws + WT_UQ); kp = 512; np = 1536; break;
      case 6: src = (const float*)P.in[25] + (size_t)l * 512 * 2048; sld = 2048; kr = 512; nr = 2048; dst = (bf16_t*)(ws + WT_UKV); kp = 512; np = 2048; break;
      case 7: src = (const float*)P.in[10] + (size_t)l * 96 * 1024; sld = 1024; kr = 96; nr = 1024; dst = (bf16_t*)(ws + WT_LW); kp = 256; np = 1024; break;
      case 8: src = (const float*)P.in[12] + (size_t)l * 96 * 1024; sld = 1024; kr = 96; nr = 1024; dst = (bf16_t*)(ws + WT_LA); kp = 256; np = 1024; break;
      case 9: src = (const float*)P.in[13] + (size_t)l * 256 * 1024; sld = 1024; kr = 256; nr = 1024; dst = (bf16_t*)(ws + WT_LG); kp = 256; np = 1024; break;
      case 10: if (l > 0) { src = (const float*)P.in[20] + (size_t)(l - 1) * 1024 * 64; sld = 64; kr = 1024; nr = 64; dst = (bf16_t*)(ws + WT_V1); kp = 1024; np = 256; } break;
      case 11: if (l > 0) { src = (const float*)P.in[21] + (size_t)(l - 1) * 64 * 1024; sld = 1024; kr = 64; nr = 1024; dst = (bf16_t*)(ws + WT_V2); kp = 256; np = 1024; } break;
      case 12: src = (const float*)P.in[34] + (size_t)l * 1024 * 2048; sld = 2048; kr = 1024; nr = 2048; dst = (bf16_t*)(ws + WT_BR); kp = 1024; np = 2048; break;
      case 13: src = (const float*)P.in[35] + (size_t)l * 1024 * 2048; sld = 2048; kr = 1024; nr = 2048; dst = (bf16_t*)(ws + WT_BR) + 1024; kp = 1024; np = 2048; break;
      case 14: src = (const float*)P.in[36] + (size_t)l * 1024 * 2048; sld = 2048; kr = 1024; nr = 2048; dst = (bf16_t*)(ws + WT_BR) + 2048; kp = 1024; np = 2048; break;
      case 15: src = (const float*)P.in[37] + (size_t)l * 2048 * 2048; sld = 2048; kr = 2048; nr = 2048; dst = (bf16_t*)(ws + WT_OUT); kp = 2048; np = 2048; break;
      case 16: src = (const float*)P.in[38] + (size_t)l * 2048 * 11264; sld = 11264; kr = 2048; nr = 11264; dst = (bf16_t*)(ws + WT_UP); kp = 2048; np = 11264; break;
      default: src = (const float*)P.in[41] + (size_t)l * DFF * 2048; sld = 2048; kr = DFF; nr = 2048; dst = (bf16_t*)(ws + WT_DN); kp = DFF; np = 2048; break;
    }
    if (src) convT(src, sld, kr, nr, dst, (j >= 12 && j <= 14) ? 3072 : kp, kp, np, cur, c, G, lds);
  }
  if ((mask >> 18) & 1u) {
    const float* sgw = (const float*)P.in[32] + (size_t)l * 8 * 128 * 128;
    bf16_t* wsg = (bf16_t*)(ws + WT_SG);
    for (int i = c * 512 + ltid(); i < 8 * 128 * 128; i += G * 512) {
      int s = i & 127, t = (i >> 7) & 127;
      wsg[i] = f2bf(s <= t ? sgw[i] : 0.f);
    }
  }
}

__device__ const float ROPE_INV[32] = {1.0f, 0.749894202f, 0.562341332f, 0.421696514f, 0.316227764f, 0.237137377f, 0.177827939f, 0.133352146f, 0.100000001f, 0.0749894232f, 0.0562341325f, 0.0421696492f, 0.0316227749f, 0.0237137377f, 0.0177827943f, 0.013335214f, 0.00999999978f, 0.00749894232f, 0.00562341325f, 0.00421696482f, 0.00316227763f, 0.00237137382f, 0.00177827943f, 0.00133352145f, 0.00100000005f, 0.000749894185f, 0.000562341302f, 0.000421696517f, 0.000316227757f, 0.00023713737f, 0.00017782794f, 0.00013335215f};
__device__ void phase_init(const Params& P, unsigned char* lds) {
  const int tid = ltid();
  const float* cvec = (const float*)P.in[1];
  for (int it = lbid(); it < 192; it += gridDim.x) {
    const int l = it / 96, rem = it % 96, cc = rem % 3, kc = rem / 3;
    const int col = cc * 4096 + tid * 4;
    const float* w = (const float*)P.in[3] + (size_t)l * D * 12288 + col;
    f32x4 acc0 = {0.f, 0.f, 0.f, 0.f}, acc1 = acc0;
#pragma unroll 8
    for (int i = kc * 64; i < kc * 64 + 64; ++i) {
      float cv = cvec[i]; float s = cv * sigmoidf_(cv);
      acc0 += s * __builtin_nontemporal_load((const f32x4*)(w + (size_t)i * 12288));
      acc1 += s * __builtin_nontemporal_load((const f32x4*)(w + (size_t)i * 12288 + 2048));
    }
    if (kc == 0) { acc0 += *(const f32x4*)((const float*)P.in[4] + l * 12288 + col); acc1 += *(const f32x4*)((const float*)P.in[4] + l * 12288 + col + 2048); }
    float* mo = (float*)(P.ws + WS_MOD) + l * 12288 + col;
    atomicAdd(mo, acc0[0]); atomicAdd(mo + 1, acc0[1]); atomicAdd(mo + 2, acc0[2]); atomicAdd(mo + 3, acc0[3]);
    atomicAdd(mo + 2048, acc1[0]); atomicAdd(mo + 2049, acc1[1]); atomicAdd(mo + 2050, acc1[2]); atomicAdd(mo + 2051, acc1[3]);
  }
  const int* pos = (const int*)P.in[2];
  float* cosb = (float*)(P.ws + WS_COS); float* sinb = (float*)(P.ws + WS_SIN);
  for (int i = lbid() * 512 + tid; i < T * 32; i += gridDim.x * 512) {
    int t = i >> 5, j = i & 31;
    float inv = ROPE_INV[j];
    float ang = (float)pos[t] * inv;
    double rev = (double)ang * 0.15915494309189535;
    rev -= rint(rev);
    cosb[i] = __builtin_amdgcn_cosf((float)rev);
    sinb[i] = __builtin_amdgcn_sinf((float)rev);
  }
  __syncthreads();
}

__device__ void phase_h(const float* __restrict__ x, const float* __restrict__ g, const float* __restrict__ sh, const float* __restrict__ sc, bf16_t* __restrict__ H) {
  const int wave = ltid() >> 6, lane = ltid() & 63;
  for (int row = lbid() * 8 + wave; row < T; row += gridDim.x * 8) {
    const float* xr = x + (size_t)row * D;
    f32x4 v[8]; float ss = 0.f;
#pragma unroll
    for (int i = 0; i < 8; ++i) { v[i] = __builtin_nontemporal_load((const f32x4*)(xr + i * 256 + lane * 4));   ss += v[i][0] * v[i][0] + v[i][1] * v[i][1] + v[i][2] * v[i][2] + v[i][3] * v[i][3]; }
    ss = wave_sum(ss);
    const float rstd = rsqrtf(ss * (1.f / D) + 1e-6f);
#pragma unroll
    for (int i = 0; i < 8; ++i) {
      const int c = i * 256 + lane * 4;
      f32x4 gg = *(const f32x4*)(g + c), s1 = *(const f32x4*)(sc + c), s0 = *(const f32x4*)(sh + c);
      f32x4 o = v[i] * rstd * gg * (1.f + s1) + s0;
      st_bf4(H + (size_t)row * D + c, o);
    }
  }
}

__device__ void phase_prep1(const Params& P, int l) {
  unsigned char* ws = P.ws;
  const bf16_t* Pb = (const bf16_t*)(ws + A_P);
  const float* mu = (const float*)P.in[8] + l * 3520;
  bf16_t* AL = (bf16_t*)(ws + A_AL); bf16_t* VB = (bf16_t*)(ws + A_VB);
  bf16_t* QL = (bf16_t*)(ws + A_QL); bf16_t* CKV = (bf16_t*)(ws + A_CKV); bf16_t* KR = (bf16_t*)(ws + A_KR);
  bf16_t* U = (bf16_t*)(ws + A_U); bf16_t* VN = (bf16_t*)(ws + A_VN);
  const float* cosb = (const float*)(ws + WS_COS); const float* sinb = (const float*)(ws + WS_SIN);
  const float* qn = (const float*)P.in[22] + l * 512; const float* kvn = (const float*)P.in[23] + l * 512;
  const float* knr = (const float*)P.in[29] + l * 64;
  const float* lnw = (const float*)P.in[30] + l * 1024; const float* lnb = (const float*)P.in[31] + l * 1024;
  const int wave = ltid() >> 6, lane = ltid() & 63;
  for (int t = lbid() * 8 + wave; t < T; t += gridDim.x * 8) {
    const bf16_t* pc = Pb + (size_t)t * PW; const bf16_t* pp = pc - PW; const bool hp = t > 0;
#pragma unroll
    for (int gq = 0; gq < 3; ++gq) {
      const int idx = (gq * 64 + lane) * 4, seg = idx >> 8, j = idx & 255;
      f32x4 val = {0.f, 0.f, 0.f, 0.f};
      if (seg == 2 || j < 96) {
        const int col = seg == 0 ? 3072 + j : (seg == 1 ? 3168 + j : 3264 + j);
        const f32x4 cur = ld_bf4(pc + col), prev = hp ? ld_bf4(pp + col) : (f32x4){0.f, 0.f, 0.f, 0.f};
        const f32x4 p = cur + (prev - cur) * *(const f32x4*)(mu + col);
#pragma unroll
        for (int e = 0; e < 4; ++e) val[e] = seg == 0 ? tanhf_(p[e]) : (seg == 1 ? p[e] : sigmoidf_(p[e]));
      }
      st_bf4(AL + (size_t)t * 768 + idx, val);
    }
    if (l > 0) {
#pragma unroll
      for (int i = 0; i < 4; ++i) {
        const int c = i * 256 + lane * 4, col = 2048 + c;
        f32x4 cur = ld_bf4(pc + col), prev = hp ? ld_bf4(pp + col) : (f32x4){0.f, 0.f, 0.f, 0.f};
        f32x4 m = *(const f32x4*)(mu + col);
        st_bf4(VB + (size_t)t * 1024 + c, cur + (prev - cur) * m);
      }
    }
#pragma unroll
    for (int which = 0; which < 2; ++which) {
      const int col = (which == 0 ? PC_DQ : PC_CKV) + lane * 8;
      f32x4 a = ld_bf4(pc + col), b = ld_bf4(pc + col + 4);
      float ss = a[0] * a[0] + a[1] * a[1] + a[2] * a[2] + a[3] * a[3] + b[0] * b[0] + b[1] * b[1] + b[2] * b[2] + b[3] * b[3];
      ss = wave_sum(ss);
      const float rstd = rsqrtf(ss * (1.f / 512.f) + 1e-6f);
      const float* gn = (which == 0 ? qn : kvn) + lane * 8;
      bf16_t* dst = (which == 0 ? QL : CKV) + (size_t)t * 512 + lane * 8;
      st_bf4(dst, a * rstd * *(const f32x4*)gn); st_bf4(dst + 4, b * rstd * *(const f32x4*)(gn + 4));
    }
    {
      float xv = bf2f(pc[PC_KR + lane]);
      float ss = wave_sum(xv * xv);
      float y = xv * rsqrtf(ss * (1.f / 64.f) + 1e-6f) * knr[lane];
      float oth = __shfl_xor(y, 32);
      const int j = lane & 31; float cs = cosb[t * 32 + j], sn = sinb[t * 32 + j];
      float o = lane < 32 ? (y * cs - oth * sn) : (oth * sn + y * cs);
      KR[(size_t)t * 64 + lane] = f2bf(o);
    }
    {
      f32x4 uu[4], vv[4]; float s1 = 0.f;
#pragma unroll
      for (int i = 0; i < 4; ++i) {
        const int c = i * 256 + lane * 4;
        uu[i] = ld_bf4(pc + PC_U + c); vv[i] = ld_bf4(pc + PC_VS + c);
#pragma unroll
        for (int e = 0; e < 4; ++e) { uu[i][e] = geluf_(uu[i][e]); vv[i][e] = geluf_(vv[i][e]); s1 += vv[i][e]; }
      }
      s1 = wave_sum(s1); const float mean = s1 * (1.f / 1024.f); float s2 = 0.f;
#pragma unroll
      for (int i = 0; i < 4; ++i)
#pragma unroll
        for (int e = 0; e < 4; ++e) { float d = vv[i][e] - mean; s2 += d * d; }
      s2 = wave_sum(s2); const float rstd = rsqrtf(s2 * (1.f / 1024.f) + 1e-5f);
#pragma unroll
      for (int i = 0; i < 4; ++i) {
        const int c = i * 256 + lane * 4;
        st_bf4(U + (size_t)t * 1024 + c, uu[i]);
        st_bf4(VN + (size_t)t * 1024 + c, (vv[i] - mean) * rstd * *(const f32x4*)(lnw + c) + *(const f32x4*)(lnb + c));
      }
    }
  }
}

__device__ void phase_prep2(const Params& P, int l, unsigned char* lds) {
  unsigned char* ws = P.ws;
  const bf16_t* Pb = (const bf16_t*)(ws + A_P);
  const float* mu = (const float*)P.in[8] + l * 3520;
  const float* w0 = (const float*)P.in[9] + l * 1024; const float* a0 = (const float*)P.in[11] + l * 1024;
  const float* k_k = (const float*)P.in[14] + l * 1024; const float* k_a = (const float*)P.in[15] + l * 1024;
  const float* v0 = (const float*)P.in[19];
  float* LW = (float*)(ws + A_LW); float* LA = (float*)(ws + A_LA); float* VG = (float*)(ws + A_VG); float* VF = (float*)(ws + WS_VF);
  float* KK = (float*)(ws + A_KK); bf16_t* KH = (bf16_t*)(ws + A_KH); bf16_t* R = (bf16_t*)(ws + A_R);
  const int wave = ltid() >> 6, lane = ltid() & 63, tid = ltid();
  const f32x4 z4 = {0.f, 0.f, 0.f, 0.f};
  for (int t = lbid() * 8 + wave; t < T; t += gridDim.x * 8) {
    const bf16_t* pc = Pb + (size_t)t * PW; const bf16_t* pp = pc - PW; const bool hp = t > 0;
#pragma unroll
    for (int i = 0; i < 4; ++i) {
      const int c = i * 256 + lane * 4; const size_t o = (size_t)t * 1024 + c;
      f32x4 rc = ld_bf4(pc + c), kc = ld_bf4(pc + 1024 + c), vc = ld_bf4(pc + 2048 + c);
      f32x4 rp = hp ? ld_bf4(pp + c) : z4, kp = hp ? ld_bf4(pp + 1024 + c) : z4, vp = hp ? ld_bf4(pp + 2048 + c) : z4;
      f32x4 r = rc + (rp - rc) * *(const f32x4*)(mu + c);
      f32x4 k = kc + (kp - kc) * *(const f32x4*)(mu + 1024 + c);
      f32x4 v = vc + (vp - vc) * *(const f32x4*)(mu + 2048 + c);
      if (l > 0) {
        f32x4 vg = *(const f32x4*)(VG + o), vf = *(const f32x4*)(VF + o), vz = *(const f32x4*)(v0 + c);
#pragma unroll
        for (int e = 0; e < 4; ++e) v[e] = v[e] + (vf[e] - v[e]) * sigmoidf_(vz[e] + vg[e]);
      } else { *(f32x4*)(VF + o) = v; }
      f32x4 lw = *(const f32x4*)(LW + o), la = *(const f32x4*)(LA + o);
      f32x4 w0v = *(const f32x4*)(w0 + c), a0v = *(const f32x4*)(a0 + c), kkv = *(const f32x4*)(k_k + c), kav = *(const f32x4*)(k_a + c);
      f32x4 dec, al, kk, kh; float ss = 0.f;
#pragma unroll
      for (int e = 0; e < 4; ++e) {
        float z = w0v[e] + lw[e];
        float sp = fmaxf(-z, 0.f) + __logf(1.f + __expf(-fabsf(z)));
        float wl = -sp - 0.5f;
        dec[e] = __expf(-__expf(wl));
        al[e] = sigmoidf_(a0v[e] + la[e]);
        kk[e] = k[e] * kkv[e]; ss += kk[e] * kk[e];
        kh[e] = k[e] * (1.f + (al[e] - 1.f) * kav[e]);
      }
      ss = sum16(ss);
      const float inv = 1.f / fmaxf(sqrtf(ss), 1e-12f);
      kk = kk * inv;
      *(f32x4*)(LW + o) = dec; *(f32x4*)(LA + o) = -(kk * al); *(f32x4*)(VG + o) = v; *(f32x4*)(KK + o) = kk;
      st_bf4(KH + o, kh); st_bf4(R + o, r);
    }
  }
  const bf16_t* QRAW = (const bf16_t*)(ws + A_QRAW); const bf16_t* KVRAW = (const bf16_t*)(ws + A_KVRAW); const bf16_t* KR = (const bf16_t*)(ws + A_KR);
  bf16_t* Q = (bf16_t*)(ws + A_Q); bf16_t* Kd = (bf16_t*)(ws + A_K); bf16_t* VT = (bf16_t*)(ws + A_VT);
  const float* cosb = (const float*)(ws + WS_COS); const float* sinb = (const float*)(ws + WS_SIN);
  const float* qnn = (const float*)P.in[26] + l * 128; const float* qnr = (const float*)P.in[27] + l * 64; const float* knn = (const float*)P.in[28] + l * 128;
  const float QS = 0.07216878364870322f * 1.4426950408889634f;
  for (int t = lbid() * 8 + wave; t < T; t += gridDim.x * 8) {
    const int j = lane & 31; const float cs = cosb[t * 32 + j], sn = sinb[t * 32 + j];
    const unsigned krv = KR[(size_t)t * 64 + lane];
    for (int h = 0; h < 8; ++h) {
      const bf16_t* qr = QRAW + (size_t)t * 1536 + h * 192;
      unsigned u = *(const unsigned*)(qr + lane * 2);
      float a = bf_lo(u), b = bf_hi(u);
      float ss = wave_sum(a * a + b * b); float rstd = rsqrtf(ss * (1.f / 128.f) + 1e-6f);
      bf16_t* qo = Q + ((size_t)h * T + t) * 192;
      *(unsigned*)(qo + lane * 2) = cvt_pk_bf16(a * rstd * qnn[lane * 2] * QS, b * rstd * qnn[lane * 2 + 1] * QS);
      float xr = bf2f(qr[128 + lane]);
      float s2 = wave_sum(xr * xr); float y = xr * rsqrtf(s2 * (1.f / 64.f) + 1e-6f) * qnr[lane];
      float oth = __shfl_xor(y, 32);
      float o = lane < 32 ? (y * cs - oth * sn) : (oth * sn + y * cs);
      qo[128 + lane] = f2bf(o * QS);
      const bf16_t* kr = KVRAW + (size_t)t * 2048 + h * 256;
      unsigned uk = *(const unsigned*)(kr + lane * 2);
      float ka = bf_lo(uk), kb = bf_hi(uk);
      float sk = wave_sum(ka * ka + kb * kb); float rk = rsqrtf(sk * (1.f / 128.f) + 1e-6f);
      bf16_t* ko = Kd + ((size_t)h * T + t) * 192;
      *(unsigned*)(ko + lane * 2) = cvt_pk_bf16(ka * rk * knn[lane * 2], kb * rk * knn[lane * 2 + 1]);
      ko[128 + lane] = (bf16_t)krv;
    }
  }
  bf16_t* tl = (bf16_t*)lds;
  for (int it = lbid(); it < 8 * (T / 64); it += gridDim.x) {
    const int h = it & 7, tb = it >> 3;
    __syncthreads();
    { const int tt = tid >> 3, dc = (tid & 7) * 16;
      const bf16_t* src = KVRAW + (size_t)(tb * 64 + tt) * 2048 + h * 256 + 128 + dc;
      *(u32x4*)(tl + tt * 136 + dc) = *(const u32x4*)src; *(u32x4*)(tl + tt * 136 + dc + 8) = *(const u32x4*)(src + 8); }
    __syncthreads();
    { const int dv = tid >> 2, tq = (tid & 3) * 16;
      unsigned o[8];
#pragma unroll
      for (int i = 0; i < 8; ++i) o[i] = (unsigned)tl[(tq + 2 * i) * 136 + dv] | ((unsigned)tl[(tq + 2 * i + 1) * 136 + dv] << 16);
      bf16_t* dst = VT + (((size_t)h * (T / 64) + tb) * 128 + dv) * 64 + tq;
      *(u32x4*)dst = (u32x4){o[0], o[1], o[2], o[3]}; *(u32x4*)(dst + 8) = (u32x4){o[4], o[5], o[6], o[7]}; }
  }
}

constexpr int SC_CH = 32, SC_STEP = 336, SC_STAGE = SC_CH * SC_STEP;
__device__ void scan_block(const Params& P, int sb, unsigned char* lds) {
  unsigned char* ws = P.ws;
  const float* LW = (const float*)(ws + A_LW); const float* LA = (const float*)(ws + A_LA); const float* VG = (const float*)(ws + A_VG);
  const float* KK = (const float*)(ws + A_KK); const bf16_t* KH = (const bf16_t*)(ws + A_KH); const bf16_t* R = (const bf16_t*)(ws + A_R);
  float* Y = (float*)(ws + A_YSC);
  float* buf = (float*)lds;
  const int head = sb >> 2, rg = sb & 3, tid = ltid();
  const bool loader = tid >= 256; const int lt = tid - 256;
  const int lane = tid & 63, wv = (tid >> 6) & 3, ks = lane & 15, myrow = wv * 4 + (lane >> 4);
  f32x4 S = {0.f, 0.f, 0.f, 0.f};
  const int hb = head * 64;
  struct Batch { f32x4 g0[2], g1[2], g2[2], gv; u32x4 h0, h1; };
  auto ld_chunk = [&](Batch& B, int c) {
    const int t0 = c * SC_CH;
#pragma unroll
    for (int i = 0; i < 2; ++i) { const int idx = lt + i * 256, st = idx >> 4, c4 = (idx & 15) * 4; const size_t o = (size_t)(t0 + st) * 1024 + hb + c4;
      B.g0[i] = *(const f32x4*)(LW + o); B.g1[i] = *(const f32x4*)(KK + o); B.g2[i] = *(const f32x4*)(LA + o); }
    { const int st = lt >> 3, c8 = (lt & 7) * 8; const size_t o = (size_t)(t0 + st) * 1024 + hb + c8; B.h0 = *(const u32x4*)(KH + o); B.h1 = *(const u32x4*)(R + o); }
    if (lt < 128) { const int st = lt >> 2, r4 = (lt & 3) * 4; B.gv = *(const f32x4*)(VG + (size_t)(t0 + st) * 1024 + hb + rg * 16 + r4); }
  };
  auto st_chunk = [&](const Batch& B, int s) {
    float* b = buf + s * SC_STAGE;
#pragma unroll
    for (int i = 0; i < 2; ++i) { const int idx = lt + i * 256, st = idx >> 4, c4 = (idx & 15) * 4; float* d = b + st * SC_STEP + c4;
      *(f32x4*)(d) = B.g0[i]; *(f32x4*)(d + 64) = B.g1[i]; *(f32x4*)(d + 128) = B.g2[i]; }
    { const int st = lt >> 3, c8 = (lt & 7) * 8; float* d = b + st * SC_STEP + c8;
      *(f32x4*)(d + 192) = (f32x4){bf_lo(B.h0.x), bf_hi(B.h0.x), bf_lo(B.h0.y), bf_hi(B.h0.y)}; *(f32x4*)(d + 196) = (f32x4){bf_lo(B.h0.z), bf_hi(B.h0.z), bf_lo(B.h0.w), bf_hi(B.h0.w)};
      *(f32x4*)(d + 256) = (f32x4){bf_lo(B.h1.x), bf_hi(B.h1.x), bf_lo(B.h1.y), bf_hi(B.h1.y)}; *(f32x4*)(d + 260) = (f32x4){bf_lo(B.h1.z), bf_hi(B.h1.z), bf_lo(B.h1.w), bf_hi(B.h1.w)}; }
    if (lt < 128) { const int st = lt >> 2, r4 = (lt & 3) * 4; *(f32x4*)(b + st * SC_STEP + 320 + r4) = B.gv; }
  };
  const int NCH = T / SC_CH;
  __syncthreads();
  if (loader) {
    Batch b0, b1, b2, b3;
    ld_chunk(b0, 0); st_chunk(b0, 0); ld_chunk(b1, 1); ld_chunk(b2, 2); ld_chunk(b3, 3); ld_chunk(b0, 4);
    __syncthreads();
    for (int c = 0; c < NCH; c += 4) {
      if (c + 1 < NCH) st_chunk(b1, (c + 1) & 1);
      if (c + 5 < NCH) ld_chunk(b1, c + 5);
      __syncthreads();
      if (c + 2 < NCH) st_chunk(b2, (c + 2) & 1);
      if (c + 6 < NCH) ld_chunk(b2, c + 6);
      __syncthreads();
      if (c + 3 < NCH) st_chunk(b3, (c + 3) & 1);
      if (c + 7 < NCH) ld_chunk(b3, c + 7);
      __syncthreads();
      if (c + 4 < NCH) st_chunk(b0, (c + 4) & 1);
      if (c + 8 < NCH) ld_chunk(b0, c + 8);
      __syncthreads();
    }
  } else {
    __builtin_amdgcn_s_setprio(2);
    __syncthreads();
    for (int c = 0; c < NCH; ++c) {
      const float* b = buf + (c & 1) * SC_STAGE;
      const float* q = b + ks * 4;
      const float* qv = b + 320 + myrow;
      float* yo = Y + (size_t)(c * SC_CH + ks) * 1024 + hb + rg * 16 + myrow;
      f32x4 w4 = *(const f32x4*)(q), k4 = *(const f32x4*)(q + 64), b4 = *(const f32x4*)(q + 128), kh4 = *(const f32x4*)(q + 192), r4 = *(const f32x4*)(q + 256);
      float v = qv[0];
      float yk = 0.f, ypart = 0.f;
#pragma unroll
      for (int s = 0; s < SC_CH; ++s) {
        f32x4 w4n, k4n, b4n, kh4n, r4n; float vn;
        if (s + 1 < SC_CH) {
          const float* qn = q + (s + 1) * SC_STEP;
          w4n = *(const f32x4*)(qn); k4n = *(const f32x4*)(qn + 64); b4n = *(const f32x4*)(qn + 128); kh4n = *(const f32x4*)(qn + 192); r4n = *(const f32x4*)(qn + 256);
          vn = qv[(s + 1) * SC_STEP];
        }
        __builtin_amdgcn_sched_barrier(0);
        if (s > 0) {
          const float y = dpp_allreduce16(ypart);
          yk = (ks == ((s - 1) & 15)) ? y : yk;
          if (((s - 1) & 15) == 15) yo[(size_t)(s - 16) * 1024] = yk;
        }
        const f32x2 pp = (f32x2){S[0], S[1]} * (f32x2){k4[0], k4[1]} + (f32x2){S[2], S[3]} * (f32x2){k4[2], k4[3]};
        const f32x4 A = S * w4 + v * kh4;
        const float ar = dpp_allreduce16(pp.x + pp.y);
        S = A + ar * b4;
        const f32x2 yy = (f32x2){S[0], S[1]} * (f32x2){r4[0], r4[1]} + (f32x2){S[2], S[3]} * (f32x2){r4[2], r4[3]};
        ypart = yy.x + yy.y;
        if (s + 1 < SC_CH) { w4 = w4n; k4 = k4n; b4 = b4n; kh4 = kh4n; r4 = r4n; v = vn; }
      }
      { const float y = dpp_allreduce16(ypart); yk = (ks == 15) ? y : yk; yo[(size_t)16 * 1024] = yk; }
      __syncthreads();
    }
    __builtin_amdgcn_s_setprio(0);
  }
}

constexpr int AT_KROW = 400, AT_VROW = 144, AT_K = 64 * AT_KROW, AT_STAGE = AT_K + 128 * AT_VROW;
__device__ void attn_block(const Params& P, int h, int qb, unsigned char* lds) {
  unsigned char* ws = P.ws;
  const bf16_t* Q = (const bf16_t*)(ws + A_Q); const bf16_t* Kd = (const bf16_t*)(ws + A_K); const bf16_t* VT = (const bf16_t*)(ws + A_VT);
  bf16_t* Y3 = (bf16_t*)(ws + A_Y3);
  const int tid = ltid(), w = tid >> 6, lane = tid & 63, fr = lane & 15, fq = lane >> 4;
  const int q0 = qb * 256, wq0 = q0 + w * 32;
  bf16x8 qf[2][6];
#pragma unroll
  for (int r2 = 0; r2 < 2; ++r2) {
    const bf16_t* qg = Q + ((size_t)h * T + wq0 + r2 * 16 + fr) * 192 + fq * 8;
#pragma unroll
    for (int kk = 0; kk < 6; ++kk) qf[r2][kk] = *(const bf16x8*)(qg + kk * 32);
  }
  f32x4 o[2][8];
#pragma unroll
  for (int r2 = 0; r2 < 2; ++r2)
#pragma unroll
    for (int n = 0; n < 8; ++n) o[r2][n] = (f32x4){0.f, 0.f, 0.f, 0.f};
  float m[2] = {-1e30f, -1e30f}, l[2] = {0.f, 0.f};
  const int ntiles = (q0 + 256) / 64;
  const bf16_t* Kh = Kd + (size_t)h * T * 192; const bf16_t* Vh = VT + (size_t)h * 128 * T;
  u32x4 kr[3], vr[2];
  auto ld_tile = [&](int kt) {
    const int k0 = kt * 64;
#pragma unroll
    for (int i = 0; i < 3; ++i) { const int c = tid + i * 512, row = c / 24, cc = c % 24; kr[i] = *(const u32x4*)(Kh + (size_t)(k0 + row) * 192 + cc * 8); }
#pragma unroll
    for (int i = 0; i < 2; ++i) { const int c = tid + i * 512; vr[i] = *(const u32x4*)(Vh + (size_t)kt * 8192 + c * 8); }
  };
  auto st_tile = [&](int s) {
    unsigned char* b = lds + s * AT_STAGE;
#pragma unroll
    for (int i = 0; i < 3; ++i) { const int c = tid + i * 512, row = c / 24, cc = c % 24; *(u32x4*)(b + row * AT_KROW + cc * 16) = kr[i]; }
#pragma unroll
    for (int i = 0; i < 2; ++i) { const int c = tid + i * 512, dv = c >> 3, cc = c & 7, x = dv & 31, row = (dv & ~31) + ((x >> 2) & 1) * 16 + (x >> 3) * 4 + (x & 3);
      *(u32x4*)(b + AT_K + row * AT_VROW + cc * 16) = vr[i]; }
  };
  __syncthreads();
  ld_tile(0); st_tile(0);
  __syncthreads();
  for (int kt = 0; kt < ntiles; ++kt) {
    const int k0 = kt * 64;
    if (kt + 1 < ntiles) ld_tile(kt + 1);
    if (k0 <= wq0 + 31) {
      const unsigned char* kb = lds + (kt & 1) * AT_STAGE; const unsigned char* vb = kb + AT_K;
      f32x4 s[2][4];
#pragma unroll
      for (int sub = 0; sub < 4; ++sub) {
        s[0][sub] = (f32x4){0.f, 0.f, 0.f, 0.f}; s[1][sub] = s[0][sub];
#pragma unroll
        for (int kk = 0; kk < 6; ++kk) {
          bf16x8 a = *(const bf16x8*)(kb + (sub * 16 + fr) * AT_KROW + (kk * 32 + fq * 8) * 2);
          s[0][sub] = __builtin_amdgcn_mfma_f32_16x16x32_bf16(a, qf[0][kk], s[0][sub], 0, 0, 0);
          s[1][sub] = __builtin_amdgcn_mfma_f32_16x16x32_bf16(a, qf[1][kk], s[1][sub], 0, 0, 0);
        }
      }
      u32x4 pk[2][2];
#pragma unroll
      for (int r2 = 0; r2 < 2; ++r2) {
        const int qrow = wq0 + r2 * 16 + fr;
        if (k0 + 63 > wq0 + r2 * 16) {
#pragma unroll
          for (int sub = 0; sub < 4; ++sub)
#pragma unroll
            for (int j = 0; j < 4; ++j) if (k0 + sub * 16 + fq * 4 + j > qrow) s[r2][sub][j] = -1e30f;
        }
        float mx = -1e30f;
#pragma unroll
        for (int sub = 0; sub < 4; ++sub)
#pragma unroll
          for (int j = 0; j < 4; ++j) mx = fmaxf(mx, s[r2][sub][j]);
        mx = xrow_max(mx);
        float mn = m[r2];
        if (__builtin_amdgcn_ballot_w64(mx - mn > 8.f) != 0ull) {
          mn = fmaxf(m[r2], mx);
          const float alpha = __builtin_amdgcn_exp2f(m[r2] - mn);
          m[r2] = mn; l[r2] *= alpha;
#pragma unroll
          for (int n = 0; n < 8; ++n) o[r2][n] *= alpha;
        }
        float ps = 0.f;
#pragma unroll
        for (int sub = 0; sub < 4; ++sub)
#pragma unroll
          for (int j = 0; j < 4; ++j) { s[r2][sub][j] = __builtin_amdgcn_exp2f(s[r2][sub][j] - mn); ps += s[r2][sub][j]; }
        l[r2] += ps;
#pragma unroll
        for (int kg = 0; kg < 2; ++kg) {
          pk[r2][kg].x = cvt_pk_bf16(s[r2][2 * kg][0], s[r2][2 * kg][1]); pk[r2][kg].y = cvt_pk_bf16(s[r2][2 * kg][2], s[r2][2 * kg][3]);
          pk[r2][kg].z = cvt_pk_bf16(s[r2][2 * kg + 1][0], s[r2][2 * kg + 1][1]); pk[r2][kg].w = cvt_pk_bf16(s[r2][2 * kg + 1][2], s[r2][2 * kg + 1][3]);
        }
      }
#pragma unroll
      for (int kg = 0; kg < 2; ++kg) {
        const bf16x8 pb0 = __builtin_bit_cast(bf16x8, pk[0][kg]), pb1 = __builtin_bit_cast(bf16x8, pk[1][kg]);
#pragma unroll
        for (int n = 0; n < 8; ++n) {
          const unsigned char* vp = vb + (n * 16 + fr) * AT_VROW + (kg * 32 + fq * 4) * 2;
          u32x2 v0 = *(const u32x2*)vp, v1 = *(const u32x2*)(vp + 32);
          const bf16x8 va = __builtin_bit_cast(bf16x8, ((u32x4){v0.x, v0.y, v1.x, v1.y}));
          o[0][n] = __builtin_amdgcn_mfma_f32_16x16x32_bf16(va, pb0, o[0][n], 0, 0, 0);
          o[1][n] = __builtin_amdgcn_mfma_f32_16x16x32_bf16(va, pb1, o[1][n], 0, 0, 0);
        }
      }
    }
    if (kt + 1 < ntiles) st_tile((kt + 1) & 1);
    __syncthreads();
  }
#pragma unroll
  for (int r2 = 0; r2 < 2; ++r2) {
    float lt = xrow_sum(l[r2]);
    const float inv = 1.f / lt;
    bf16_t* yo = Y3 + (size_t)(wq0 + r2 * 16 + fr) * 3072 + 1024 + h * 128 + fq * 8;
#pragma unroll
    for (int n = 0; n < 8; n += 2) *(u32x4*)(yo + (n >> 1) * 32) = pack8(o[r2][n] * inv, o[r2][n + 1] * inv);
  }
}

__device__ void sg_item(const Params& P, int l, int n, int g, unsigned char* lds) {
  unsigned char* ws = P.ws;
  const bf16_t* VN = (const bf16_t*)(ws + A_VN); const bf16_t* U = (const bf16_t*)(ws + A_U); const bf16_t* WS = (const bf16_t*)(ws + WT_SG);
  bf16_t* Y3 = (bf16_t*)(ws + A_Y3);
  const float* sb = (const float*)P.in[33] + (size_t)l * 1024 + g * 128;
  bf16_t* vt = (bf16_t*)lds;
  const int tid = ltid(), w = tid >> 6, lane = tid & 63, fr = lane & 15, fq = lane >> 4;
  __syncthreads();
#pragma unroll
  for (int i = 0; i < 4; ++i) {
    const int c = tid + i * 512, s = c >> 4, c8 = (c & 15) * 8;
    u32x4 v = *(const u32x4*)(VN + (size_t)(n * 128 + s) * 1024 + g * 128 + c8);
    const unsigned vv[4] = {v.x, v.y, v.z, v.w};
#pragma unroll
    for (int e = 0; e < 4; ++e) { vt[(c8 + 2 * e) * 136 + s] = (bf16_t)(vv[e] & 0xffff); vt[(c8 + 2 * e + 1) * 136 + s] = (bf16_t)(vv[e] >> 16); }
  }
  __syncthreads();
  const int trow = w * 16 + fr;
  bf16x8 wf[4];
  const bf16_t* wp = WS + ((size_t)g * 128 + trow) * 128 + fq * 8;
#pragma unroll
  for (int kk = 0; kk < 4; ++kk) wf[kk] = *(const bf16x8*)(wp + kk * 32);
  const int tt = n * 128 + trow;
  const float bias = sb[trow];
#pragma unroll
  for (int nn = 0; nn < 8; ++nn) {
    f32x4 acc = {0.f, 0.f, 0.f, 0.f};
#pragma unroll
    for (int kk = 0; kk < 4; ++kk) {
      bf16x8 b = *(const bf16x8*)(vt + (nn * 16 + fr) * 136 + kk * 32 + fq * 8);
      acc = __builtin_amdgcn_mfma_f32_16x16x32_bf16(b, wf[kk], acc, 0, 0, 0);
    }
    const int cc = g * 128 + nn * 16 + fq * 4;
    f32x4 u = ld_bf4(U + (size_t)tt * 1024 + cc);
    st_bf4(Y3 + (size_t)tt * 3072 + 2048 + cc, u * (acc + bias));
  }
}

__device__ void phase_post(const Params& P, int l) {
  unsigned char* ws = P.ws;
  const float* Y = (const float*)(ws + A_YSC); const float* VG = (const float*)(ws + A_VG);
  const bf16_t* KH = (const bf16_t*)(ws + A_KH); const bf16_t* R = (const bf16_t*)(ws + A_R); const bf16_t* LG = (const bf16_t*)(ws + A_LG);
  bf16_t* Y3 = (bf16_t*)(ws + A_Y3);
  const float* rk = (const float*)P.in[16] + l * 1024; const float* lw = (const float*)P.in[17] + l * 1024; const float* lb = (const float*)P.in[18] + l * 1024;
  const int wave = ltid() >> 6, lane = ltid() & 63;
  for (int t = lbid() * 8 + wave; t < T; t += gridDim.x * 8) {
#pragma unroll
    for (int i = 0; i < 4; ++i) {
      const int c = i * 256 + lane * 4; const size_t o = (size_t)t * 1024 + c;
      f32x4 y = *(const f32x4*)(Y + o), v = *(const f32x4*)(VG + o), r = ld_bf4(R + o), kh = ld_bf4(KH + o), g = ld_bf4(LG + o);
      f32x4 rkv = *(const f32x4*)(rk + c);
      float s1 = sum16(y[0] + y[1] + y[2] + y[3]); const float mean = s1 * (1.f / 64.f);
      f32x4 d = y - mean;
      float s2 = sum16(d[0] * d[0] + d[1] * d[1] + d[2] * d[2] + d[3] * d[3]); const float rstd = rsqrtf(s2 * (1.f / 64.f) + 64e-5f);
      float bs = sum16(r[0] * kh[0] * rkv[0] + r[1] * kh[1] * rkv[1] + r[2] * kh[2] * rkv[2] + r[3] * kh[3] * rkv[3]);
      f32x4 out = (d * rstd * *(const f32x4*)(lw + c) + *(const f32x4*)(lb + c) + bs * v) * g;
      st_bf4(Y3 + (size_t)t * 3072 + c, out);
    }
  }
}

__device__ void phase_conv(const Params& P, int l) {
  unsigned char* ws = P.ws;
  const bf16_t* UP = (const bf16_t*)(ws + A_UP); bf16_t* ACT = (bf16_t*)(ws + A_ACT);
  const float* cw = (const float*)P.in[39] + (size_t)l * 3 * 11264; const float* cb = (const float*)P.in[40] + (size_t)l * 11264;
  const int tid = ltid(), wave = tid >> 6, lane = tid & 63;
  constexpr int RC = 32, NCG = DFF / 256;
  const f32x4 z4 = {0.f, 0.f, 0.f, 0.f};
  for (int item = lbid() * 8 + wave; item < (T / RC) * NCG; item += gridDim.x * 8) {
    const int cg = item % NCG, t0 = (item / NCG) * RC;
    const int j = (cg * 64 + lane) * 4;
    const f32x4 wg0 = *(const f32x4*)(cw + j), wg1 = *(const f32x4*)(cw + 11264 + j), wg2 = *(const f32x4*)(cw + 2 * 11264 + j), bg = *(const f32x4*)(cb + j);
    const f32x4 wv0 = *(const f32x4*)(cw + DFF + j), wv1 = *(const f32x4*)(cw + 11264 + DFF + j), wv2 = *(const f32x4*)(cw + 2 * 11264 + DFF + j), bv = *(const f32x4*)(cb + DFF + j);
    const bf16_t* up = UP + (size_t)t0 * 11264 + j;
    f32x4 g1 = t0 >= 1 ? ld_bf4(up - 11264) : z4, g2 = t0 >= 2 ? ld_bf4(up - 2 * 11264) : z4;
    f32x4 v1 = t0 >= 1 ? ld_bf4(up - 11264 + DFF) : z4, v2 = t0 >= 2 ? ld_bf4(up - 2 * 11264 + DFF) : z4;
    bf16_t* ao = ACT + (size_t)t0 * DFF + j;
#pragma unroll 8
    for (int t = 0; t < RC; ++t) {
      const u32x2 gr = __builtin_nontemporal_load((const u32x2*)(up + (size_t)t * 11264)), vr = __builtin_nontemporal_load((const u32x2*)(up + (size_t)t * 11264 + DFF));
      const f32x4 g0 = {bf_lo(gr.x), bf_hi(gr.x), bf_lo(gr.y), bf_hi(gr.y)}, v0 = {bf_lo(vr.x), bf_hi(vr.x), bf_lo(vr.y), bf_hi(vr.y)};
      const f32x4 cgv = bg + wg2 * g0 + wg1 * g1 + wg0 * g2;
      const f32x4 cvv = bv + wv2 * v0 + wv1 * v1 + wv0 * v2;
      f32x4 o;
#pragma unroll
      for (int e = 0; e < 4; ++e) o[e] = cgv[e] * sigmoidf_(cgv[e]) * cvv[e];
      st_bf4(ao + (size_t)t * DFF, o);
      g2 = g1; g1 = g0; v2 = v1; v1 = v0;
    }
  }
}

constexpr int NPL = 14, NPH = 1 + NL * NPL;
DEVI int phase_njobs(int pl, int l) {
  switch (pl) { case 1: return 1; case 3: return l > 0 ? 6 : 5; case 4: return l > 0 ? 1 : 0; case 6: return 1; case 8: return 1; case 9: return 1; case 11: return 1; case 13: return 1; default: return 0; }
}
DEVI GJob get_job(const Params& P, int pl, int l, int j) {
  unsigned char* ws = P.ws; GJob g{}; g.keep = 0;
  const float* mod = (const float*)(ws + WS_MOD) + l * 12288;
  switch (pl) {
    case 1: g.A = (const bf16_t*)(ws + A_H); g.lda = 2048; g.Bt = (const bf16_t*)(ws + WT_IN + (size_t)(l & 1) * WTIN_BYTES); g.ldb = 2048; g.N = PW; g.K = 2048; g.mode = 0; g.out = ws + A_P; g.ldo = PW; break;
    case 3:
      if (j == 0) { g.A = (const bf16_t*)(ws + A_QL); g.lda = 512; g.Bt = (const bf16_t*)(ws + WT_UQ); g.ldb = 512; g.N = 1536; g.K = 512; g.mode = 0; g.out = ws + A_QRAW; g.ldo = 1536; }
      else if (j == 1) { g.A = (const bf16_t*)(ws + A_CKV); g.lda = 512; g.Bt = (const bf16_t*)(ws + WT_UKV); g.ldb = 512; g.N = 2048; g.K = 512; g.mode = 0; g.out = ws + A_KVRAW; g.ldo = 2048; }
      else if (j == 2) { g.A = (const bf16_t*)(ws + A_AL); g.lda = 768; g.Bt = (const bf16_t*)(ws + WT_LW); g.ldb = 256; g.N = 1024; g.K = 256; g.mode = 1; g.out = ws + A_LW; g.ldo = 1024; }
      else if (j == 3) { g.A = (const bf16_t*)(ws + A_AL) + 256; g.lda = 768; g.Bt = (const bf16_t*)(ws + WT_LA); g.ldb = 256; g.N = 1024; g.K = 256; g.mode = 1; g.out = ws + A_LA; g.ldo = 1024; }
      else if (j == 4) { g.A = (const bf16_t*)(ws + A_AL) + 512; g.lda = 768; g.Bt = (const bf16_t*)(ws + WT_LG); g.ldb = 256; g.N = 1024; g.K = 256; g.mode = 0; g.out = ws + A_LG; g.ldo = 1024; }
      else { g.A = (const bf16_t*)(ws + A_VB); g.lda = 1024; g.Bt = (const bf16_t*)(ws + WT_V1); g.ldb = 1024; g.N = 256; g.K = 1024; g.mode = 0; g.out = ws + A_VL; g.ldo = 256; }
      break;
    case 4: g.A = (const bf16_t*)(ws + A_VL); g.lda = 256; g.Bt = (const bf16_t*)(ws + WT_V2); g.ldb = 256; g.N = 1024; g.K = 256; g.mode = 1; g.out = ws + A_VG; g.ldo = 1024; break;
    case 6: g.A = (const bf16_t*)(ws + A_H); g.lda = 2048; g.Bt = (const bf16_t*)(ws + WT_IN + (size_t)(l & 1) * WTIN_BYTES) + (size_t)PW * 2048; g.ldb = 2048; g.N = NGATE; g.K = 2048; g.mode = 2; g.out = ws + A_GATE; g.ldo = NGATE; break;
    case 8: g.A = (const bf16_t*)(ws + A_Y3); g.lda = 3072; g.Bt = (const bf16_t*)(ws + WT_BR); g.ldb = 3072; g.N = 2048; g.K = 3072; g.mode = 7;
            g.out = ws + A_MERG; g.aux = ws + A_GATE; g.ldo = 2048; break;
    case 9: g.A = (const bf16_t*)(ws + A_MERG); g.lda = 2048; g.Bt = (const bf16_t*)(ws + WT_OUT); g.ldb = 2048; g.N = 2048; g.K = 2048; g.mode = 6;
            g.out = ws + WS_X; g.aux = (l == 0) ? P.in[0] : (const void*)(ws + WS_X); g.aux2 = mod + 2 * 2048; g.ldo = 2048; break;
    case 11: g.A = (const bf16_t*)(ws + A_H); g.lda = 2048; g.Bt = (const bf16_t*)(ws + WT_UP); g.ldb = 2048; g.N = 11264; g.K = 2048; g.mode = 0; g.out = ws + A_UP; g.ldo = 11264; break;
    default: g.A = (const bf16_t*)(ws + A_ACT); g.lda = DFF; g.Bt = (const bf16_t*)(ws + WT_DN); g.ldb = DFF; g.N = 2048; g.K = DFF; g.mode = 6;
            g.out = (l == NL - 1) ? (void*)P.out : (void*)(ws + WS_X); g.aux = ws + WS_X; g.aux2 = mod + 5 * 2048; g.ldo = 2048; break;
  }
  g.A = (const bf16_t*)uptr(g.A); g.Bt = (const bf16_t*)uptr(g.Bt); g.out = (void*)uptr(g.out); g.aux = uptr(g.aux); g.aux2 = uptr(g.aux2);
  g.lda = __builtin_amdgcn_readfirstlane(g.lda); g.ldb = __builtin_amdgcn_readfirstlane(g.ldb); g.ldo = __builtin_amdgcn_readfirstlane(g.ldo);
  g.N = __builtin_amdgcn_readfirstlane(g.N); g.K = __builtin_amdgcn_readfirstlane(g.K); g.mode = __builtin_amdgcn_readfirstlane(g.mode); g.keep = __builtin_amdgcn_readfirstlane(g.keep);
  return g;
}

__global__ void __launch_bounds__(512) fwd_kernel(Params Parg) {
  extern __shared__ __attribute__((aligned(16))) unsigned char lds[];
  cg::grid_group grid = cg::this_grid();
  const int ph_lo = Parg.ph_lo, ph_hi = Parg.ph_hi;
  __shared__ uint4 xb_words;
  if (__builtin_amdgcn_workitem_id_x() == 0) xb_words = make_uint4(0u, 0u, 0u, 0u);
  __syncthreads();
  XcdBarrier xb = xcd_barrier_post((unsigned*)(Parg.ws + WS_BAR), (volatile LAS unsigned*)&xb_words);
  for (int ph = ph_lo; ph < ph_hi; ++ph) {
    const __attribute__((address_space(4))) Params* pp = (const __attribute__((address_space(4))) Params*)__builtin_amdgcn_kernarg_segment_ptr();
    asm volatile("" : "+s"(pp));
    const Params& P = *(const Params*)pp;
    unsigned char* ws = P.ws;
    int l = 0, pl = -1;
    if (ph > 0) { l = (ph - 1) / NPL; pl = (ph - 1) % NPL; }
    const float* mod = (const float*)(ws + WS_MOD) + l * 12288;
    const int nrep = ((ph > 0 && ((PROBE_MASK >> pl) & 1)) || (ph == 0 && ((PROBE_MASK >> 30) & 1))) ? 2 : 1;
    for (int rep = 0; rep < nrep; ++rep) {
    int c = lbid(), G = gridDim.x;
    if (ph == 0) { if (EN_INIT) phase_init(P, lds); }
    else switch (pl) {
      case 0: {
        const float* xin = (l == 0) ? (const float*)P.in[0] : (const float*)(ws + WS_X);
        if (EN_MISC) phase_h(xin, (const float*)P.in[5] + l * D, mod, mod + 2048, (bf16_t*)(ws + A_H));
      } break;
      case 2: if (EN_PREP) phase_prep1(P, l); break;
      case 5: if (EN_PREP) phase_prep2(P, l, lds); break;
      case 6: {
        if ((int)lbid() < NSCAN) { if (EN_SCAN && (rep == 0 || (PROBE_PART & 1))) scan_block(P, lbid(), lds); c = -1; }
        else {
          c = lbid() - NSCAN; G = gridDim.x - NSCAN;
          __syncthreads();
        }
      } break;
      case 7: if (EN_MISC) phase_post(P, l); break;
      case 10: if (EN_MISC) phase_h((const float*)(ws + WS_X), (const float*)P.in[6] + l * D, mod + 3 * 2048, mod + 4 * 2048, (bf16_t*)(ws + A_H)); break;
      case 12: if (EN_MISC) phase_conv(P, l); break;
      default: break;
    }
    {
      constexpr unsigned CM_IN = 0x1Fu, CM_SMALL = 0xFE0u, CM_LATE = 0x3F000u, CM_SG = 1u << 18;
      unsigned cm0 = 0, cm1 = 0; int cl1 = l + 1;
      int cc = c, cG = G;
      const int slot = (c & 7) * (G >> 3) + (c >> 3);
      if (ph == 0) cm0 = CM_IN | CM_SMALL | CM_SG;
      else if (pl == 1 && rep == 0) { cm0 = (1u << 15) | (1u << 16); cc = slot - 96; cG = 160; }
      else if (pl == 11 && l + 1 < NL && rep == 0) { cm1 = CM_IN | CM_SMALL | CM_SG; cc = slot - 128; cG = 128; }
      else if (pl == 6 && c >= 0 && (rep == 0 || (PROBE_PART & 16))) cm0 = (7u << 12) | (1u << 17);
      for (int k = 0; k < 2; ++k) { const unsigned m = k ? cm1 : cm0; if (m && EN_INIT && cc >= 0) convert_layer(P, k ? cl1 : l, m, cc, cG, lds); }
    }
    if (ph > 0) {
      const int nj = phase_njobs(pl, l);
      int cursor = 0;
      for (int j = 0; j < nj; ++j) { GJob jb = get_job(P, pl, l, j); if (EN_GEMM && (pl != 6 || rep == 0 || (PROBE_PART & 8))) gemm_job(jb, cursor, c, G, lds); }
    }
    if (ph > 0 && pl == 6 && c >= 0) {
      if (EN_ATTN && (rep == 0 || (PROBE_PART & 2))) {
        unsigned* qctr = (unsigned*)(ws + WS_BAR) + 3600 + (l * 2 + rep) * 64;
        volatile int* slot = (volatile int*)(lds + 131056);
        for (;;) {
          __syncthreads();
          if (ltid() == 0) *slot = (int)atomicAdd(qctr, 1u);
          __syncthreads();
          const int idx = *slot;
          if (idx >= 256) break;
          attn_block(P, idx & 7, 31 - (idx >> 3), lds);
        }
      }
      for (int it = c; it < 512; it += G) if (EN_SG && (rep == 0 || (PROBE_PART & 4))) sg_item(P, l, it >> 3, it & 7, lds);
      __syncthreads();
    }
    }
    if (ph_hi > 100000) grid.sync();
    if (ph + 1 < ph_hi && !(pl == 4 && l == 0)) xcd_barrier(xb);
  }
}

extern "C" void kernel_launch(void* const* d_in, const int* in_sizes, int n_in, void* d_out, int out_size, void* d_ws, size_t ws_size, hipStream_t stream) {
  static int grid = 0;
  if (grid == 0) {
    if (n_in != 42 || ws_size < WS_END) { fprintf(stderr, "kernel_launch: unexpected n_in %d / ws %zu (need %zu)\n", n_in, ws_size, (size_t)WS_END); grid = -1; return; }
    int dev = 0, cus = 0, per_cu = 0;
    hipGetDevice(&dev);
    hipDeviceGetAttribute(&cus, hipDeviceAttributeMultiprocessorCount, dev);
    if (hipFuncSetAttribute((const void*)fwd_kernel, hipFuncAttributeMaxDynamicSharedMemorySize, LDS_BYTES) != hipSuccess) { fprintf(stderr, "kernel_launch: hipFuncSetAttribute failed\n"); grid = -1; return; }
    hipOccupancyMaxActiveBlocksPerMultiprocessor(&per_cu, (const void*)fwd_kernel, 512, LDS_BYTES);
    if (per_cu < 1) { fprintf(stderr, "kernel_launch: occupancy query returned %d\n", per_cu); per_cu = 1; }
    (void)hipGetLastError();
    grid = cus;
  }
  if (grid < 0) return;
  Params p{};
  for (int i = 0; i < 42; ++i) p.in[i] = d_in[i];
  p.out = (float*)d_out; p.ws = (unsigned char*)d_ws;
  if (hipMemsetAsync((char*)d_ws + WS_MOD, 0, WS_BAR + 16384 - WS_MOD, stream) != hipSuccess)
#if N_LAUNCH_MODE == 1
  p.ph_lo = 0; p.ph_hi = NPH;
  void* args[] = {&p};
  hipError_t e = hipLaunchCooperativeKernel((const void*)fwd_kernel, dim3(grid), dim3(512), args, LDS_BYTES, stream);
  if (e != hipSuccess) fprintf(stderr, "cooperative launch failed: %s (grid %d)\n", hipGetErrorString(e), grid);
#else
  for (int ph = 0; ph < NPH; ++ph) {
    p.ph_lo = ph; p.ph_hi = ph + 1;
    hipLaunchKernelGGL(fwd_kernel, dim3(grid), dim3(512), LDS_BYTES, stream, p);
  }
#endif
}
```

```cpp
#include <hip/hip_runtime.h>
#include <hip/hip_cooperative_groups.h>
#include <cstdio>
namespace cg = cooperative_groups;

#ifndef EN_MISC
#define EN_MISC 1
#endif
#ifndef EN_INIT
#define EN_INIT 1
#endif
#ifndef EN_PREP
#define EN_PREP 1
#endif
#ifndef EN_SCAN
#define EN_SCAN 1
#endif
#ifndef EN_ATTN
#define EN_ATTN 1
#endif
#ifndef EN_SG
#define EN_SG 1
#endif
#ifndef EN_GEMM
#define EN_GEMM 1
#endif
#ifndef PROBE_MASK
#define PROBE_MASK 0
#endif
#ifndef PROBE_PART
#define PROBE_PART 0
#endif
#ifndef N_LAUNCH_MODE
#define N_LAUNCH_MODE 1
#endif

typedef unsigned short bf16_t;
typedef short bf16x8 __attribute__((ext_vector_type(8)));
typedef float f32x4 __attribute__((ext_vector_type(4)));
typedef float f32x2 __attribute__((ext_vector_type(2)));
typedef unsigned u32x4 __attribute__((ext_vector_type(4)));
typedef unsigned u32x2 __attribute__((ext_vector_type(2)));
#define DEVI __device__ __forceinline__

constexpr int T = 8192, D = 2048, NL = 2;
constexpr int NIN = 12800;
constexpr int PW = 6912;
constexpr int PC_DQ = 3584, PC_CKV = 4096, PC_KR = 4608, PC_U = 4864, PC_VS = 5888;
constexpr int NGATE = 6144;
constexpr int DFF = 5632;
constexpr int NSCAN = 64;

constexpr size_t al256(size_t x) { return (x + 255) & ~(size_t)255; }
constexpr size_t WS_MOD = 0;
constexpr size_t WS_BAR = al256(WS_MOD + (size_t)NL * 6 * D * 4);
constexpr size_t WS_COS = WS_BAR + 16384;
constexpr size_t WS_SIN = WS_COS + (size_t)T * 32 * 4;
constexpr size_t WS_X   = WS_SIN + (size_t)T * 32 * 4;
constexpr size_t WS_VF  = WS_X + (size_t)T * D * 4;
constexpr size_t WT_IN  = WS_VF + (size_t)T * 1024 * 4;
constexpr size_t WTIN_BYTES = (size_t)13056 * 2048 * 2;
constexpr size_t WT_UQ  = WT_IN + 2 * WTIN_BYTES;
constexpr size_t WT_UKV = WT_UQ + (size_t)1536 * 512 * 2;
constexpr size_t WT_LW  = WT_UKV + (size_t)2048 * 512 * 2;
constexpr size_t WT_LA  = WT_LW + (size_t)1024 * 256 * 2;
constexpr size_t WT_LG  = WT_LA + (size_t)1024 * 256 * 2;
constexpr size_t WT_V1  = WT_LG + (size_t)1024 * 256 * 2;
constexpr size_t WT_V2  = WT_V1 + (size_t)256 * 1024 * 2;
constexpr size_t WT_BR  = WT_V2 + (size_t)1024 * 256 * 2;
constexpr size_t WT_OUT = WT_BR + (size_t)3 * 2048 * 1024 * 2;
constexpr size_t WT_UP  = WT_OUT + (size_t)2048 * 2048 * 2;
constexpr size_t WT_DN  = WT_UP + (size_t)11264 * 2048 * 2;
constexpr size_t WT_SG  = WT_DN + (size_t)2048 * 5632 * 2;
constexpr size_t A_H    = WT_SG + (size_t)8 * 128 * 128 * 2;
constexpr size_t A_P    = A_H + (size_t)T * 2048 * 2;
constexpr size_t A_GATE = A_P;
constexpr size_t A_LW   = A_P + (size_t)T * PW * 2;
constexpr size_t A_LA   = A_LW + (size_t)T * 1024 * 4;
constexpr size_t A_VG   = A_LA + (size_t)T * 1024 * 4;
constexpr size_t A_MACC = A_LW;
constexpr size_t A_MERG = A_VG;
constexpr size_t A_LG   = A_VG + (size_t)T * 1024 * 4;
constexpr size_t A_VL   = A_LG + (size_t)T * 1024 * 2;
constexpr size_t A_QRAW = A_VL + (size_t)T * 256 * 2;
constexpr size_t A_KVRAW= A_QRAW + (size_t)T * 1536 * 2;
constexpr size_t A_AL   = A_KVRAW + (size_t)T * 2048 * 2;
constexpr size_t A_VB   = A_AL + (size_t)T * 768 * 2;
constexpr size_t A_YSC  = A_QRAW;
constexpr size_t A_Y3   = A_YSC + (size_t)T * 1024 * 4;
constexpr size_t A_QL   = A_VB + (size_t)T * 1024 * 2;
constexpr size_t A_CKV  = A_QL + (size_t)T * 512 * 2;
constexpr size_t A_KR   = A_CKV + (size_t)T * 512 * 2;
constexpr size_t A_U    = A_KR + (size_t)T * 64 * 2;
constexpr size_t A_VN   = A_U + (size_t)T * 1024 * 2;
constexpr size_t A_KK   = A_VN + (size_t)T * 1024 * 2;
constexpr size_t A_KH   = A_KK + (size_t)T * 1024 * 4;
constexpr size_t A_R    = A_KH + (size_t)T * 1024 * 2;
constexpr size_t A_Q    = A_R + (size_t)T * 1024 * 2;
constexpr size_t A_K    = A_Q + (size_t)8 * T * 192 * 2;
constexpr size_t A_VT   = A_K + (size_t)8 * T * 192 * 2;
constexpr size_t WS_END = A_VT + (size_t)8 * 128 * T * 2;
constexpr size_t A_UP   = A_P;
constexpr size_t A_ACT  = A_UP + (size_t)T * 11264 * 2;
static_assert(A_Y3 + (size_t)T * 3072 * 2 <= A_QL, "alias overflow");
static_assert(A_ACT + (size_t)T * DFF * 2 <= WS_END, "ffn alias overflow");
static_assert(WS_END < 858000000ull, "workspace too large");

constexpr int LDS_BYTES = 131072;

struct Params {
  const void* in[42];
  float* out;
  unsigned char* ws;
  int ph_lo, ph_hi;
};

DEVI int lbid() { int t = __builtin_amdgcn_workgroup_id_x(); asm volatile("" : "+s"(t)); return t; }
DEVI const void* uptr(const void* p) { unsigned long long v = (unsigned long long)p; unsigned lo = __builtin_amdgcn_readfirstlane((unsigned)v), hi = __builtin_amdgcn_readfirstlane((unsigned)(v >> 32)); return (const void*)(((unsigned long long)hi << 32) | lo); }
DEVI int ltid() { int t = __builtin_amdgcn_workitem_id_x(); asm volatile("" : "+v"(t)); return t; }
DEVI unsigned cvt_pk_bf16(float lo, float hi) { unsigned r; asm("v_cvt_pk_bf16_f32 %0, %1, %2" : "=v"(r) : "v"(lo), "v"(hi)); return r; }
DEVI float bf_lo(unsigned u) { return __uint_as_float(u << 16); }
DEVI float bf_hi(unsigned u) { return __uint_as_float(u & 0xffff0000u); }
DEVI float bf2f(bf16_t h) { return __uint_as_float(((unsigned)h) << 16); }
DEVI bf16_t f2bf(float f) { return (bf16_t)(cvt_pk_bf16(f, 0.f) & 0xffffu); }
DEVI float sigmoidf_(float x) { return 1.f / (1.f + __expf(-x)); }
DEVI float tanhf_(float x) { x = fminf(fmaxf(x, -15.f), 15.f); float t = __expf(2.f * x); return (t - 1.f) / (t + 1.f); }
DEVI float geluf_(float x) { return 0.5f * x * (1.f + tanhf_(0.7978845608028654f * (x + 0.044715f * x * x * x))); }
DEVI float wave_sum(float v) {
#pragma unroll
  for (int o = 32; o > 0; o >>= 1) v += __shfl_xor(v, o);
  return v;
}
DEVI float sum16(float v) {
#pragma unroll
  for (int o = 8; o > 0; o >>= 1) v += __shfl_xor(v, o);
  return v;
}
DEVI float dpp_allreduce16(float x) {
  x += __builtin_bit_cast(float, __builtin_amdgcn_update_dpp(0, __builtin_bit_cast(int, x), 0xB1, 0xF, 0xF, true));
  x += __builtin_bit_cast(float, __builtin_amdgcn_update_dpp(0, __builtin_bit_cast(int, x), 0x4E, 0xF, 0xF, true));
  x += __builtin_bit_cast(float, __builtin_amdgcn_update_dpp(0, __builtin_bit_cast(int, x), 0x141, 0xF, 0xF, true));
  x += __builtin_bit_cast(float, __builtin_amdgcn_update_dpp(0, __builtin_bit_cast(int, x), 0x140, 0xF, 0xF, true));
  return x;
}
DEVI float xrow_max(float x) {
  auto a = __builtin_amdgcn_permlane16_swap(__float_as_uint(x), __float_as_uint(x), false, false);
  float m1 = fmaxf(__uint_as_float(a[0]), __uint_as_float(a[1]));
  auto b = __builtin_amdgcn_permlane32_swap(__float_as_uint(m1), __float_as_uint(m1), false, false);
  return fmaxf(__uint_as_float(b[0]), __uint_as_float(b[1]));
}
DEVI float xrow_sum(float x) {
  auto a = __builtin_amdgcn_permlane16_swap(__float_as_uint(x), __float_as_uint(x), false, false);
  float m1 = __uint_as_float(a[0]) + __uint_as_float(a[1]);
  auto b = __builtin_amdgcn_permlane32_swap(__float_as_uint(m1), __float_as_uint(m1), false, false);
  return __uint_as_float(b[0]) + __uint_as_float(b[1]);
}
DEVI f32x4 ld_bf4(const bf16_t* p) { u32x2 u = *(const u32x2*)p; return (f32x4){bf_lo(u.x), bf_hi(u.x), bf_lo(u.y), bf_hi(u.y)}; }
DEVI void st_bf4(bf16_t* p, f32x4 v) { u32x2 u; u.x = cvt_pk_bf16(v[0], v[1]); u.y = cvt_pk_bf16(v[2], v[3]); *(u32x2*)p = u; }


#define XB_TMO      128
#define XB_XCNT(j)  (256  + 64 * (j))
#define XB_XSUB(j)  (1280 + 64 * (j))
#define XB_XGEN(j)  (2304 + 64 * (j))
#define XB_TOP      3328
#define XB_TOPGEN   3392
#define XCD_BAR_WORDS 3456
#define XB_SPIN_CAP (1u << 20)
#define LAS __attribute__((address_space(3)))
DEVI unsigned xb_ld(unsigned* p) { return __hip_atomic_load(p, __ATOMIC_RELAXED, __HIP_MEMORY_SCOPE_AGENT); }
DEVI unsigned xb_add(unsigned* p, unsigned v) { return __hip_atomic_fetch_add(p, v, __ATOMIC_RELAXED, __HIP_MEMORY_SCOPE_AGENT); }
DEVI unsigned xb_xcc_id() { return (unsigned)__builtin_amdgcn_s_getreg((3 << 11) | 20) & 0xFu; }
#define XB_SPIN(cond, bar) do { unsigned _sp = 0; while (cond) { __builtin_amdgcn_s_sleep(4); \
    if ((++_sp & 255u) == 0u) { if (xb_ld(&(bar)[XB_TMO])) break; if (_sp > XB_SPIN_CAP) { atomicAdd(&(bar)[XB_TMO], 1u); break; } } } } while (0)
struct XcdBarrier { unsigned* bar; unsigned x; volatile LAS unsigned* st; };
DEVI XcdBarrier xcd_barrier_post(unsigned* bar, volatile LAS unsigned* st) {
  XcdBarrier b; b.bar = bar; b.x = xb_xcc_id(); b.st = st;
  if (__builtin_amdgcn_workitem_id_x() == 0) (void)xb_add(&bar[XB_XCNT(b.x)], 1u);
  return b;
}
DEVI void xcd_barrier_complete(unsigned* bar, unsigned x, unsigned& nloc, unsigned& nx) {
  const unsigned G = gridDim.x;
  unsigned sum, cnt, mine, sp = 0u;
  for (;;) {
    sum = 0u; cnt = 0u; mine = 0u;
#pragma unroll
    for (unsigned j = 0; j < 16; ++j) { const unsigned c = xb_ld(&bar[XB_XCNT(j)]); sum += c; cnt += (c > 0u) ? 1u : 0u; mine = (j == x) ? c : mine; }
    if (sum == G) break;
    __builtin_amdgcn_s_sleep(1);
    if ((++sp & 255u) == 0u) { if (xb_ld(&bar[XB_TMO])) break; if (sp > XB_SPIN_CAP) { atomicAdd(&bar[XB_TMO], 1u); break; } }
  }
  nloc = mine > 0u ? mine : 1u; nx = cnt > 0u ? cnt : 1u;
}
DEVI void xcd_barrier(const XcdBarrier& b) {
  asm volatile("s_waitcnt vmcnt(0)" ::: "memory");
  __syncthreads();
  if (__builtin_amdgcn_workitem_id_x() == 0) {
    unsigned* bar = b.bar;
    __builtin_amdgcn_s_waitcnt(0);
    unsigned nloc = b.st[0], nx = b.st[1];
    if (nloc == 0u) { xcd_barrier_complete(bar, b.x, nloc, nx); b.st[0] = nloc; b.st[1] = nx; }
    const unsigned old = xb_add(&bar[XB_XSUB(b.x)], 1u);
    const unsigned gen = old / nloc;
    if (old + 1u == (gen + 1u) * nloc) {
      __builtin_amdgcn_fence(__ATOMIC_RELEASE, "agent");
      asm volatile("s_waitcnt vmcnt(0)" ::: "memory");
      const unsigned og = xb_add(&bar[XB_TOP], 1u);
      const unsigned tg = og / nx;
      if (og + 1u == (tg + 1u) * nx) xb_add(&bar[XB_TOPGEN], 1u);
      else XB_SPIN(xb_ld(&bar[XB_TOPGEN]) == tg, bar);
      __builtin_amdgcn_fence(__ATOMIC_ACQUIRE, "agent");
      xb_add(&bar[XB_XGEN(b.x)], 1u);
      asm volatile("s_waitcnt vmcnt(0)" ::: "memory");
    } else {
      XB_SPIN(xb_ld(&bar[XB_XGEN(b.x)]) == gen, bar);
      __builtin_amdgcn_fence(__ATOMIC_ACQUIRE, "agent");
      asm volatile("s_waitcnt vmcnt(0)" ::: "memory");
    }
  }
  __syncthreads();
}

constexpr int BM = 256, BK = 64, HALF = 128, HT = HALF * BK, WGM = 8;
struct GJob { const bf16_t* A; const bf16_t* Bt; void* out; const void* aux; const void* aux2; int lda, ldb, ldo, N, K, mode, keep; };

DEVI int lds_byte(int r, int c) { int st = (r >> 4) * 2 + (c >> 5), rr = r & 15, cc = c & 31, ob = rr * 64 + cc * 2; return st * 1024 + (ob ^ (((ob >> 9) & 1) << 5)); }
DEVI void stage_rc(int b, int& R, int& C) { int st = b >> 10, sb = b & 1023, swz = sb ^ (((sb >> 9) & 1) << 5); R = (st >> 1) * 16 + (swz >> 6); C = (st & 1) * 32 + ((swz & 63) >> 1); }

DEVI int perm32(int rho) { const int n = rho >> 4, i = rho & 15; return 8 * (i >> 2) + 4 * n + (i & 3); }
DEVI u32x4 pack8(f32x4 a, f32x4 b) { u32x4 o; o.x = cvt_pk_bf16(a[0], a[1]); o.y = cvt_pk_bf16(a[2], a[3]); o.z = cvt_pk_bf16(b[0], b[1]); o.w = cvt_pk_bf16(b[2], b[3]); return o; }
DEVI void gemm_epi(const GJob& jb, int row, int col, f32x4 v0, f32x4 v1) {
  const int mode = jb.mode;
  if (mode == 0) { *(u32x4*)((bf16_t*)jb.out + (size_t)row * jb.ldo + col) = pack8(v0, v1); }
  else if (mode == 1) { float* p = (float*)jb.out + (size_t)row * jb.ldo + col; *(f32x4*)p = v0; *(f32x4*)(p + 4) = v1; }
  else if (mode == 2) { f32x4 s0, s1; for (int i = 0; i < 4; ++i) { s0[i] = sigmoidf_(v0[i]); s1[i] = sigmoidf_(v1[i]); } *(u32x4*)((bf16_t*)jb.out + (size_t)row * jb.ldo + col) = pack8(s0, s1); }
  else if (mode == 7) {
    const u32x4 g = *(const u32x4*)((const bf16_t*)jb.aux + (size_t)row * NGATE + 2 * 2048 + col);
    const f32x4 g0 = {bf_lo(g.x), bf_hi(g.x), bf_lo(g.y), bf_hi(g.y)}, g1 = {bf_lo(g.z), bf_hi(g.z), bf_lo(g.w), bf_hi(g.w)};
    *(u32x4*)((bf16_t*)jb.out + (size_t)row * 2048 + col) = pack8(g0 * v0, g1 * v1);
  } else {
    const float* xp = (const float*)jb.aux + (size_t)row * jb.ldo + col; const float* gp = (const float*)jb.aux2 + col;
    float* op = (float*)jb.out + (size_t)row * jb.ldo + col;
    const f32x4 x0 = *(const f32x4*)xp, x1 = *(const f32x4*)(xp + 4), t0 = *(const f32x4*)gp, t1 = *(const f32x4*)(gp + 4);
    *(f32x4*)op = x0 + t0 * v0; *(f32x4*)(op + 4) = x1 + t1 * v1;
  }
}

DEVI void gemm_tile(const GJob& jb, int brow, int bcol, unsigned char* shm_) {
  LAS unsigned char* lds = (LAS unsigned char*)shm_;
  const int lda = jb.lda, ldb = jb.ldb, K = jb.K;
  const int tid = ltid(), wid = __builtin_amdgcn_readfirstlane(tid >> 6), lane = tid & 63, wr = wid >> 2, wc = wid & 3, fr = lane & 15, fq = lane >> 4;
  unsigned voffA[2], voffB[2];
#pragma unroll
  for (int i = 0; i < 2; ++i) { int R, C; stage_rc(tid * 16 + i * 8192, R, C); const int Rb = (R & ~31) + perm32(R & 31); voffA[i] = (unsigned)(R * lda + C) * 2u; voffB[i] = (unsigned)(Rb * ldb + C) * 2u; }
  const size_t hA = (size_t)HALF * lda * 2, hB = (size_t)HALF * ldb * 2;
  const unsigned ldsw = (unsigned)wid * 1024u;
  const int aoff = lds_byte(wr * 64 + fr, fq * 8), boff = lds_byte(wc * 32 + fr, fq * 8);
  constexpr int HTB = HT * 2;
#define SA(b,h) (((b)*2+(h))*HTB)
#define SB(b,h) ((4+(b)*2+(h))*HTB)
#define STAGE(bufoff,gbase,voff) do{ _Pragma("unroll") for(int _i=0;_i<2;++_i) \
    __builtin_amdgcn_global_load_lds((const unsigned*)((const char*)(gbase)+(voff)[_i]),(LAS unsigned*)(lds+(bufoff)+ldsw+_i*8192),16,0,0);}while(0)
#define LDA(dst,b,h) do{ _Pragma("unroll") for(int m=0;m<4;++m) _Pragma("unroll") for(int k=0;k<2;++k) dst[m][k]=*(const LAS bf16x8*)(lds+SA(b,h)+aoff+m*2048+k*1024);}while(0)
#define LDB(dst,b,h) do{ _Pragma("unroll") for(int n=0;n<2;++n) _Pragma("unroll") for(int k=0;k<2;++k) dst[n][k]=*(const LAS bf16x8*)(lds+SB(b,h)+boff+n*2048+k*1024);}while(0)
#define MMA(ai,bj,At_,Bt_) do{__builtin_amdgcn_s_setprio(1); \
    _Pragma("unroll") for(int m=0;m<4;++m) _Pragma("unroll") for(int n=0;n<2;++n) _Pragma("unroll") for(int k=0;k<2;++k) \
      acc[ai][bj][m][n]=__builtin_amdgcn_mfma_f32_16x16x32_bf16(Bt_[n][k],At_[m][k],acc[ai][bj][m][n],0,0,0); \
    __builtin_amdgcn_s_setprio(0);}while(0)
#define WAIT_V(n) asm volatile("s_waitcnt vmcnt(" #n ")":::"memory")
#define WAIT_L(n) asm volatile("s_waitcnt lgkmcnt(" #n ")":::"memory")
#define BAR __builtin_amdgcn_s_barrier()
#define SCHED __builtin_amdgcn_sched_barrier(0)
  f32x4 acc[2][2][4][2];
#pragma unroll
  for (int a = 0; a < 2; ++a)
#pragma unroll
    for (int b = 0; b < 2; ++b)
#pragma unroll
      for (int m = 0; m < 4; ++m)
#pragma unroll
        for (int n = 0; n < 2; ++n) acc[a][b][m][n] = (f32x4){0.f, 0.f, 0.f, 0.f};
  bf16x8 At[4][2], B0[2][2], B1[2][2];
  const int nt = K / BK;
  const char* cA = (const char*)jb.A + (size_t)brow * lda * 2; const char* cB = (const char*)jb.Bt + (size_t)bcol * ldb * 2;
  STAGE(SB(0,0),cB,voffB); STAGE(SA(0,0),cA,voffA);
  STAGE(SB(0,1),cB+hB,voffB); STAGE(SA(0,1),cA+hA,voffA);
  if (wr == 1) BAR;
  WAIT_V(4); BAR;
  STAGE(SB(1,0),cB+128,voffB); STAGE(SA(1,0),cA+128,voffA); STAGE(SB(1,1),cB+hB+128,voffB);
  WAIT_V(6); BAR;
  for (int t = 0; t < nt - 2; t += 2) {
    if (jb.mode == 7 && (t == 16 || t == 32)) {
      const int seg = (t >> 4) - 1;
      const bf16_t* gp = (const bf16_t*)jb.aux + (size_t)(brow + wr * 64 + fr) * NGATE + seg * 2048 + bcol + wc * 32 + fq * 8;
#pragma unroll
      for (int ai = 0; ai < 2; ++ai)
#pragma unroll
        for (int m = 0; m < 4; ++m)
#pragma unroll
          for (int bj = 0; bj < 2; ++bj)
#pragma unroll
            for (int n = 0; n < 2; ++n) {
              const bf16_t* g = gp + (size_t)(ai * HALF + m * 16) * NGATE + bj * HALF + n * 4;
              const f32x4 g0 = ld_bf4(g), g1 = ld_bf4(g + 2048);
#pragma unroll
              for (int e = 0; e < 4; ++e) acc[ai][bj][m][n][e] *= g0[e] * __builtin_amdgcn_rcpf(fmaxf(g1[e], 1e-30f));
            }
    }
    const char* a1 = cA + (size_t)(t + 1) * 128; const char* a2 = a1 + 128; const char* a3 = a2 + 128;
    const char* b2 = cB + (size_t)(t + 2) * 128; const char* b3 = b2 + 128;
    LDB(B0,0,0); SCHED; LDA(At,0,0); STAGE(SA(1,1),a1+hA,voffA);
    WAIT_L(8); BAR; WAIT_L(0); MMA(0,0,At,B0); BAR; SCHED;
    LDB(B1,0,1); STAGE(SB(0,0),b2,voffB);
    BAR; WAIT_L(0); MMA(0,1,At,B1); BAR;
    LDA(At,0,1); STAGE(SA(0,0),a2,voffA);
    BAR; WAIT_L(0); MMA(1,0,At,B0); BAR; SCHED;
    STAGE(SB(0,1),b2+hB,voffB);
    WAIT_V(6); BAR; MMA(1,1,At,B1); BAR;
    LDB(B0,1,0); SCHED; LDA(At,1,0); STAGE(SA(0,1),a2+hA,voffA);
    WAIT_L(8); BAR; WAIT_L(0); MMA(0,0,At,B0); BAR; SCHED;
    LDB(B1,1,1); STAGE(SB(1,0),b3,voffB);
    BAR; WAIT_L(0); MMA(0,1,At,B1); BAR;
    LDA(At,1,1); STAGE(SA(1,0),a3,voffA);
    BAR; WAIT_L(0); MMA(1,0,At,B0); BAR; SCHED;
    STAGE(SB(1,1),b3+hB,voffB);
    WAIT_V(6); BAR; MMA(1,1,At,B1); BAR;
  }
  { LDB(B0,0,0); LDA(At,0,0); STAGE(SA(1,1),cA+(size_t)(nt-1)*128+hA,voffA);
    BAR; WAIT_L(0); MMA(0,0,At,B0); BAR;
    LDB(B1,0,1); BAR; WAIT_L(0); MMA(0,1,At,B1); BAR;
    LDA(At,0,1); WAIT_V(4); BAR; WAIT_L(0); MMA(1,0,At,B0); MMA(1,1,At,B1); BAR; }
  { LDB(B0,1,0); LDA(At,1,0); WAIT_V(2); BAR; WAIT_L(0); MMA(0,0,At,B0); BAR;
    LDB(B1,1,1); WAIT_V(0); BAR; WAIT_L(0); MMA(0,1,At,B1); BAR;
    LDA(At,1,1); BAR; WAIT_L(0); MMA(1,0,At,B0); MMA(1,1,At,B1); BAR; }
  if (wr == 0) BAR;
#pragma unroll
  for (int ai = 0; ai < 2; ++ai)
#pragma unroll
    for (int m = 0; m < 4; ++m)
#pragma unroll
      for (int bj = 0; bj < 2; ++bj)
        gemm_epi(jb, brow + ai * HALF + wr * 64 + m * 16 + fr, bcol + bj * HALF + wc * 32 + fq * 8, acc[ai][bj][m][0], acc[ai][bj][m][1]);
  __syncthreads();
#undef SA
#undef SB
#undef STAGE
#undef LDA
#undef LDB
#undef MMA
}

DEVI void gemm_job(const GJob& jb, int& cursor, int c, int G, unsigned char* lds) {
  const int nM = T / BM, nN = jb.N / BM, ntile = nM * nN;
  if (c >= 0) {
    const int slot = ((G & 7) == 0) ? (c & 7) * (G >> 3) + (c >> 3) : c;
    int first = (slot - cursor % G + G) % G;
    for (int i = first; i < ntile; i += G) {
      const int nig = WGM * nN, gid = i / nig, fm = gid * WGM, gsz = (nM - fm) < WGM ? (nM - fm) : WGM;
      const int pm = fm + ((i % nig) % gsz), pn = (i % nig) / gsz;
      gemm_tile(jb, pm * BM, pn * BM, lds);
    }
  }
  if (!jb.keep) cursor += ntile;
}

DEVI void convT(const float* __restrict__ src, int src_ld, int k_real, int n_real, bf16_t* __restrict__ dst, int dld, int k_pad, int n_pad, int& cursor, int c, int G, unsigned char* lds) {
  float* tile = (float*)lds;
  const int tk = k_pad / 128, tn = n_pad / 128, nt = tk * tn, tid = ltid(), w = tid >> 6, lane = tid & 63;
  int first = (c - cursor % G + G) % G;
  for (int i = first; i < nt; i += G) {
    const int n0 = (i / tk) * 128, k0 = (i % tk) * 128;
    { const int n = n0 + lane * 2; const bool nok = n < n_real;
      f32x2 v[16];
#pragma unroll
      for (int r = 0; r < 16; ++r) {
        const int k = k0 + w * 16 + r;
        v[r] = (f32x2){0.f, 0.f};
        if (nok && k < k_real) v[r] = __builtin_nontemporal_load((const f32x2*)(src + (size_t)k * src_ld + n));
      }
#pragma unroll
      for (int r = 0; r < 16; ++r) *(f32x2*)(tile + (w * 16 + r) * 130 + lane * 2) = v[r]; }
    __syncthreads();
    { const int n = tid >> 2, q = tid & 3;
#pragma unroll
      for (int jj = 0; jj < 4; ++jj) {
        const int k8 = (jj * 4 + q) * 8;
        const float* tp = tile + k8 * 130 + n;
        u32x4 o; o.x = cvt_pk_bf16(tp[0], tp[130]); o.y = cvt_pk_bf16(tp[260], tp[390]); o.z = cvt_pk_bf16(tp[520], tp[650]); o.w = cvt_pk_bf16(tp[780], tp[910]);
        *(u32x4*)(dst + (size_t)(n0 + n) * dld + k0 + k8) = o;
      } }
    __syncthreads();
  }
  cursor += nt;
}

__device__ void convert_layer(const Params& P, int l, unsigned mask, int c, int G, unsigned char* lds) {
  unsigned char* ws = P.ws;
  int cur = 0;
  for (int j = 0; j < 18; ++j) {
    if (!((mask >> j) & 1u)) continue;
    const float* src = nullptr; bf16_t* dst = nullptr; int sld = 0, kr = 0, nr = 0, kp = 0, np = 0;
    const float* w_in = (const float*)P.in[7] + (size_t)l * D * NIN;
    bf16_t* wtin = (bf16_t*)(ws + WT_IN + (size_t)(l & 1) * WTIN_BYTES);
    switch (j) {
      case 0: src = w_in; sld = NIN; kr = 2048; nr = 3520; dst = wtin; kp = 2048; np = 3584; break;
      case 1: src = w_in + 3520; sld = NIN; kr = 2048; nr = 512; dst = wtin + (size_t)3584 * 2048; kp = 2048; np = 512; break;
      case 2: src = w_in + 4032; sld = NIN; kr = 2048; nr = 576; dst = wtin + (size_t)4096 * 2048; kp = 2048; np = 768; break;
      case 3: src = w_in + 4608; sld = NIN; kr = 2048; nr = 2048; dst = wtin + (size_t)4864 * 2048; kp = 2048; np = 2048; break;
      case 4: src = w_in + 6656; sld = NIN; kr = 2048; nr = 6144; dst = wtin + (size_t)6912 * 2048; kp = 2048; np = 6144; break;
      case 5: src = (const float*)P.in[24] + (size_t)l * 512 * 1536; sld = 1536; kr = 512; nr = 1536; dst = (bf16_t*)(ws + WT_UQ); kp = 512; np = 1536; break;
      case 6: src = (const float*)P.in[25] + (size_t)l * 512 * 2048; sld = 2048; kr = 512; nr = 2048; dst = (bf16_t*)(ws + WT_UKV); kp = 512; np = 2048; break;
      case 7: src = (const float*)P.in[10] + (size_t)l * 96 * 1024; sld = 1024; kr = 96; nr = 1024; dst = (bf16_t*)(ws + WT_LW); kp = 256; np = 1024; break;
      case 8: src = (const float*)P.in[12] + (size_t)l * 96 * 1024; sld = 1024; kr = 96; nr = 1024; dst = (bf16_t*)(ws + WT_LA); kp = 256; np = 1024; break;
      case 9: src = (const float*)P.in[13] + (size_t)l * 256 * 1024; sld = 1024; kr = 256; nr = 1024; dst = (bf16_t*)(ws + WT_LG); kp = 256; np = 1024; break;
      case 10: if (l > 0) { src = (const float*)P.in[20] + (size_t)(l - 1) * 1024 * 64; sld = 64; kr = 1024; nr = 64; dst = (bf16_t*)(ws + WT_V1); kp = 1024; np = 256; } break;
      case 11: if (l > 0) { src = (const float*)P.in[21] + (size_t)(l - 1) * 64 * 1024; sld = 1024; kr = 64; nr = 1024; dst = (bf16_t*)(ws + WT_V2); kp = 256; np = 1024; } break;
      case 12: src = (const float*)P.in[34] + (size_t)l * 1024 * 2048; sld = 2048; kr = 1024; nr = 2048; dst = (bf16_t*)(ws + WT_BR); kp = 1024; np = 2048; break;
      case 13: src = (const float*)P.in[35] + (size_t)l * 1024 * 2048; sld = 2048; kr = 1024; nr = 2048; dst = (bf16_t*)(ws + WT_BR) + 1024; kp = 1024; np = 2048; break;
      case 14: src = (const float*)P.in[36] + (size_t)l * 1024 * 2048; sld = 2048; kr = 1024; nr = 2048; dst = (bf16_t*)(ws + WT_BR) + 2048; kp = 1024; np = 2048; break;
      case 15: src = (const float*)P.in[37] + (size_t)l * 2048 * 2048; sld = 2048; kr = 2048; nr = 2048; dst = (bf16_t*)(ws + WT_OUT); kp = 2048; np = 2048; break;
      case 16: src = (const float*)P.in[38] + (size_t)l * 2048 * 11264; sld = 11264; kr = 2048; nr = 11264; dst = (bf16_t*)(ws + WT_UP); kp = 2048; np = 11264; break;
      default: src = (const float*)P.in[41] + (size_t)l * DFF * 2048; sld = 2048; kr = DFF; nr = 2048; dst = (bf16_t*)(ws + WT_DN); kp = DFF; np = 2048; break;
    }
    if (src) convT(src, sld, kr, nr, dst, (j >= 12 && j <= 14) ? 3072 : kp, kp, np, cur, c, G, lds);
  }
  if ((mask >> 18) & 1u) {
    const float* sgw = (const float*)P.in[32] + (size_t)l * 8 * 128 * 128;
    bf16_t* wsg = (bf16_t*)(ws + WT_SG);
    for (int i = c * 512 + ltid(); i < 8 * 128 * 128; i += G * 512) {
      int s = i & 127, t = (i >> 7) & 127;
      wsg[i] = f2bf(s <= t ? sgw[i] : 0.f);
    }
  }
}

__device__ const float ROPE_INV[32] = {1.0f, 0.749894202f, 0.562341332f, 0.421696514f, 0.316227764f, 0.237137377f, 0.177827939f, 0.133352146f, 0.100000001f, 0.0749894232f, 0.0562341325f, 0.0421696492f, 0.0316227749f, 0.0237137377f, 0.0177827943f, 0.013335214f, 0.00999999978f, 0.00749894232f, 0.00562341325f, 0.00421696482f, 0.00316227763f, 0.00237137382f, 0.00177827943f, 0.00133352145f, 0.00100000005f, 0.000749894185f, 0.000562341302f, 0.000421696517f, 0.000316227757f, 0.00023713737f, 0.00017782794f, 0.00013335215f};
__device__ void phase_init(const Params& P, unsigned char* lds) {
  const int tid = ltid();
  const float* cvec = (const float*)P.in[1];
  for (int it = lbid(); it < 192; it += gridDim.x) {
    const int l = it / 96, rem = it % 96, cc = rem % 3, kc = rem / 3;
    const int col = cc * 4096 + tid * 4;
    const float* w = (const float*)P.in[3] + (size_t)l * D * 12288 + col;
    f32x4 acc0 = {0.f, 0.f, 0.f, 0.f}, acc1 = acc0;
#pragma unroll 8
    for (int i = kc * 64; i < kc * 64 + 64; ++i) {
      float cv = cvec[i]; float s = cv * sigmoidf_(cv);
      acc0 += s * __builtin_nontemporal_load((const f32x4*)(w + (size_t)i * 12288));
      acc1 += s * __builtin_nontemporal_load((const f32x4*)(w + (size_t)i * 12288 + 2048));
    }
    if (kc == 0) { acc0 += *(const f32x4*)((const float*)P.in[4] + l * 12288 + col); acc1 += *(const f32x4*)((const float*)P.in[4] + l * 12288 + col + 2048); }
    float* mo = (float*)(P.ws + WS_MOD) + l * 12288 + col;
    atomicAdd(mo, acc0[0]); atomicAdd(mo + 1, acc0[1]); atomicAdd(mo + 2, acc0[2]); atomicAdd(mo + 3, acc0[3]);
    atomicAdd(mo + 2048, acc1[0]); atomicAdd(mo + 2049, acc1[1]); atomicAdd(mo + 2050, acc1[2]); atomicAdd(mo + 2051, acc1[3]);
  }
  const int* pos = (const int*)P.in[2];
  float* cosb = (float*)(P.ws + WS_COS); float* sinb = (float*)(P.ws + WS_SIN);
  for (int i = lbid() * 512 + tid; i < T * 32; i += gridDim.x * 512) {
    int t = i >> 5, j = i & 31;
    float inv = ROPE_INV[j];
    float ang = (float)pos[t] * inv;
    double rev = (double)ang * 0.15915494309189535;
    rev -= rint(rev);
    cosb[i] = __builtin_amdgcn_cosf((float)rev);
    sinb[i] = __builtin_amdgcn_sinf((float)rev);
  }
  __syncthreads();
}

__device__ void phase_h(const float* __restrict__ x, const float* __restrict__ g, const float* __restrict__ sh, const float* __restrict__ sc, bf16_t* __restrict__ H) {
  const int wave = ltid() >> 6, lane = ltid() & 63;
  for (int row = lbid() * 8 + wave; row < T; row += gridDim.x * 8) {
    const float* xr = x + (size_t)row * D;
    f32x4 v[8]; float ss = 0.f;
#pragma unroll
    for (int i = 0; i < 8; ++i) { v[i] = __builtin_nontemporal_load((const f32x4*)(xr + i * 256 + lane * 4));   ss += v[i][0] * v[i][0] + v[i][1] * v[i][1] + v[i][2] * v[i][2] + v[i][3] * v[i][3]; }
    ss = wave_sum(ss);
    const float rstd = rsqrtf(ss * (1.f / D) + 1e-6f);
#pragma unroll
    for (int i = 0; i < 8; ++i) {
      const int c = i * 256 + lane * 4;
      f32x4 gg = *(const f32x4*)(g + c), s1 = *(const f32x4*)(sc + c), s0 = *(const f32x4*)(sh + c);
      f32x4 o = v[i] * rstd * gg * (1.f + s1) + s0;
      st_bf4(H + (size_t)row * D + c, o);
    }
  }
}

__device__ void phase_prep1(const Params& P, int l) {
  unsigned char* ws = P.ws;
  const bf16_t* Pb = (const bf16_t*)(ws + A_P);
  const float* mu = (const float*)P.in[8] + l * 3520;
  bf16_t* AL = (bf16_t*)(ws + A_AL); bf16_t* VB = (bf16_t*)(ws + A_VB);
  bf16_t* QL = (bf16_t*)(ws + A_QL); bf16_t* CKV = (bf16_t*)(ws + A_CKV); bf16_t* KR = (bf16_t*)(ws + A_KR);
  bf16_t* U = (bf16_t*)(ws + A_U); bf16_t* VN = (bf16_t*)(ws + A_VN);
  const float* cosb = (const float*)(ws + WS_COS); const float* sinb = (const float*)(ws + WS_SIN);
  const float* qn = (const float*)P.in[22] + l * 512; const float* kvn = (const float*)P.in[23] + l * 512;
  const float* knr = (const float*)P.in[29] + l * 64;
  const float* lnw = (const float*)P.in[30] + l * 1024; const float* lnb = (const float*)P.in[31] + l * 1024;
  const int wave = ltid() >> 6, lane = ltid() & 63;
  for (int t = lbid() * 8 + wave; t < T; t += gridDim.x * 8) {
    const bf16_t* pc = Pb + (size_t)t * PW; const bf16_t* pp = pc - PW; const bool hp = t > 0;
#pragma unroll
    for (int gq = 0; gq < 3; ++gq) {
      const int idx = (gq * 64 + lane) * 4, seg = idx >> 8, j = idx & 255;
      f32x4 val = {0.f, 0.f, 0.f, 0.f};
      if (seg == 2 || j < 96) {
        const int col = seg == 0 ? 3072 + j : (seg == 1 ? 3168 + j : 3264 + j);
        const f32x4 cur = ld_bf4(pc + col), prev = hp ? ld_bf4(pp + col) : (f32x4){0.f, 0.f, 0.f, 0.f};
        const f32x4 p = cur + (prev - cur) * *(const f32x4*)(mu + col);
#pragma unroll
        for (int e = 0; e < 4; ++e) val[e] = seg == 0 ? tanhf_(p[e]) : (seg == 1 ? p[e] : sigmoidf_(p[e]));
      }
      st_bf4(AL + (size_t)t * 768 + idx, val);
    }
    if (l > 0) {
#pragma unroll
      for (int i = 0; i < 4; ++i) {
        const int c = i * 256 + lane * 4, col = 2048 + c;
        f32x4 cur = ld_bf4(pc + col), prev = hp ? ld_bf4(pp + col) : (f32x4){0.f, 0.f, 0.f, 0.f};
        f32x4 m = *(const f32x4*)(mu + col);
        st_bf4(VB + (size_t)t * 1024 + c, cur + (prev - cur) * m);
      }
    }
#pragma unroll
    for (int which = 0; which < 2; ++which) {
      const int col = (which == 0 ? PC_DQ : PC_CKV) + lane * 8;
      f32x4 a = ld_bf4(pc + col), b = ld_bf4(pc + col + 4);
      float ss = a[0] * a[0] + a[1] * a[1] + a[2] * a[2] + a[3] * a[3] + b[0] * b[0] + b[1] * b[1] + b[2] * b[2] + b[3] * b[3];
      ss = wave_sum(ss);
      const float rstd = rsqrtf(ss * (1.f / 512.f) + 1e-6f);
      const float* gn = (which == 0 ? qn : kvn) + lane * 8;
      bf16_t* dst = (which == 0 ? QL : CKV) + (size_t)t * 512 + lane * 8;
      st_bf4(dst, a * rstd * *(const f32x4*)gn); st_bf4(dst + 4, b * rstd * *(const f32x4*)(gn + 4));
    }
    {
      float xv = bf2f(pc[PC_KR + lane]);
      float ss = wave_sum(xv * xv);
      float y = xv * rsqrtf(ss * (1.f / 64.f) + 1e-6f) * knr[lane];
      float oth = __shfl_xor(y, 32);
      const int j = lane & 31; float cs = cosb[t * 32 + j], sn = sinb[t * 32 + j];
      float o = lane < 32 ? (y * cs - oth * sn) : (oth * sn + y * cs);
      KR[(size_t)t * 64 + lane] = f2bf(o);
    }
    {
      f32x4 uu[4], vv[4]; float s1 = 0.f;
#pragma unroll
      for (int i = 0; i < 4; ++i) {
        const int c = i * 256 + lane * 4;
        uu[i] = ld_bf4(pc + PC_U + c); vv[i] = ld_bf4(pc + PC_VS + c);
#pragma unroll
        for (int e = 0; e < 4; ++e) { uu[i][e] = geluf_(uu[i][e]); vv[i][e] = geluf_(vv[i][e]); s1 += vv[i][e]; }
      }
      s1 = wave_sum(s1); const float mean = s1 * (1.f / 1024.f); float s2 = 0.f;
#pragma unroll
      for (int i = 0; i < 4; ++i)
#pragma unroll
        for (int e = 0; e < 4; ++e) { float d = vv[i][e] - mean; s2 += d * d; }
      s2 = wave_sum(s2); const float rstd = rsqrtf(s2 * (1.f / 1024.f) + 1e-5f);
#pragma unroll
      for (int i = 0; i < 4; ++i) {
        const int c = i * 256 + lane * 4;
        st_bf4(U + (size_t)t * 1024 + c, uu[i]);
        st_bf4(VN + (size_t)t * 1024 + c, (vv[i] - mean) * rstd * *(const f32x4*)(lnw + c) + *(const f32x4*)(lnb + c));
      }
    }
  }
}

__device__ void phase_prep2(const Params& P, int l, unsigned char* lds) {
  unsigned char* ws = P.ws;
  const bf16_t* Pb = (const bf16_t*)(ws + A_P);
  const float* mu = (const float*)P.in[8] + l * 3520;
  const float* w0 = (const float*)P.in[9] + l * 1024; const float* a0 = (const float*)P.in[11] + l * 1024;
  const float* k_k = (const float*)P.in[14] + l * 1024; const float* k_a = (const float*)P.in[15] + l * 1024;
  const float* v0 = (const float*)P.in[19];
  float* LW = (float*)(ws + A_LW); float* LA = (float*)(ws + A_LA); float* VG = (float*)(ws + A_VG); float* VF = (float*)(ws + WS_VF);
  float* KK = (float*)(ws + A_KK); bf16_t* KH = (bf16_t*)(ws + A_KH); bf16_t* R = (bf16_t*)(ws + A_R);
  const int wave = ltid() >> 6, lane = ltid() & 63, tid = ltid();
  const f32x4 z4 = {0.f, 0.f, 0.f, 0.f};
  for (int t = lbid() * 8 + wave; t < T; t += gridDim.x * 8) {
    const bf16_t* pc = Pb + (size_t)t * PW; const bf16_t* pp = pc - PW; const bool hp = t > 0;
#pragma unroll
    for (int i = 0; i < 4; ++i) {
      const int c = i * 256 + lane * 4; const size_t o = (size_t)t * 1024 + c;
      f32x4 rc = ld_bf4(pc + c), kc = ld_bf4(pc + 1024 + c), vc = ld_bf4(pc + 2048 + c);
      f32x4 rp = hp ? ld_bf4(pp + c) : z4, kp = hp ? ld_bf4(pp + 1024 + c) : z4, vp = hp ? ld_bf4(pp + 2048 + c) : z4;
      f32x4 r = rc + (rp - rc) * *(const f32x4*)(mu + c);
      f32x4 k = kc + (kp - kc) * *(const f32x4*)(mu + 1024 + c);
      f32x4 v = vc + (vp - vc) * *(const f32x4*)(mu + 2048 + c);
      if (l > 0) {
        f32x4 vg = *(const f32x4*)(VG + o), vf = *(const f32x4*)(VF + o), vz = *(const f32x4*)(v0 + c);
#pragma unroll
        for (int e = 0; e < 4; ++e) v[e] = v[e] + (vf[e] - v[e]) * sigmoidf_(vz[e] + vg[e]);
      } else { *(f32x4*)(VF + o) = v; }
      f32x4 lw = *(const f32x4*)(LW + o), la = *(const f32x4*)(LA + o);
      f32x4 w0v = *(const f32x4*)(w0 + c), a0v = *(const f32x4*)(a0 + c), kkv = *(const f32x4*)(k_k + c), kav = *(const f32x4*)(k_a + c);
      f32x4 dec, al, kk, kh; float ss = 0.f;
#pragma unroll
      for (int e = 0; e < 4; ++e) {
        float z = w0v[e] + lw[e];
        float sp = fmaxf(-z, 0.f) + __logf(1.f + __expf(-fabsf(z)));
        float wl = -sp - 0.5f;
        dec[e] = __expf(-__expf(wl));
        al[e] = sigmoidf_(a0v[e] + la[e]);
        kk[e] = k[e] * kkv[e]; ss += kk[e] * kk[e];
        kh[e] = k[e] * (1.f + (al[e] - 1.f) * kav[e]);
      }
      ss = sum16(ss);
      const float inv = 1.f / fmaxf(sqrtf(ss), 1e-12f);
      kk = kk * inv;
      *(f32x4*)(LW + o) = dec; *(f32x4*)(LA + o) = -(kk * al); *(f32x4*)(VG + o) = v; *(f32x4*)(KK + o) = kk;
      st_bf4(KH + o, kh); st_bf4(R + o, r);
    }
  }
  const bf16_t* QRAW = (const bf16_t*)(ws + A_QRAW); const bf16_t* KVRAW = (const bf16_t*)(ws + A_KVRAW); const bf16_t* KR = (const bf16_t*)(ws + A_KR);
  bf16_t* Q = (bf16_t*)(ws + A_Q); bf16_t* Kd = (bf16_t*)(ws + A_K); bf16_t* VT = (bf16_t*)(ws + A_VT);
  const float* cosb = (const float*)(ws + WS_COS); const float* sinb = (const float*)(ws + WS_SIN);
  const float* qnn = (const float*)P.in[26] + l * 128; const float* qnr = (const float*)P.in[27] + l * 64; const float* knn = (const float*)P.in[28] + l * 128;
  const float QS = 0.07216878364870322f * 1.4426950408889634f;
  for (int t = lbid() * 8 + wave; t < T; t += gridDim.x * 8) {
    const int j = lane & 31; const float cs = cosb[t * 32 + j], sn = sinb[t * 32 + j];
    const unsigned krv = KR[(size_t)t * 64 + lane];
    for (int h = 0; h < 8; ++h) {
      const bf16_t* qr = QRAW + (size_t)t * 1536 + h * 192;
      unsigned u = *(const unsigned*)(qr + lane * 2);
      float a = bf_lo(u), b = bf_hi(u);
      float ss = wave_sum(a * a + b * b); float rstd = rsqrtf(ss * (1.f / 128.f) + 1e-6f);
      bf16_t* qo = Q + ((size_t)h * T + t) * 192;
      *(unsigned*)(qo + lane * 2) = cvt_pk_bf16(a * rstd * qnn[lane * 2] * QS, b * rstd * qnn[lane * 2 + 1] * QS);
      float xr = bf2f(qr[128 + lane]);
      float s2 = wave_sum(xr * xr); float y = xr * rsqrtf(s2 * (1.f / 64.f) + 1e-6f) * qnr[lane];
      float oth = __shfl_xor(y, 32);
      float o = lane < 32 ? (y * cs - oth * sn) : (oth * sn + y * cs);
      qo[128 + lane] = f2bf(o * QS);
      const bf16_t* kr = KVRAW + (size_t)t * 2048 + h * 256;
      unsigned uk = *(const unsigned*)(kr + lane * 2);
      float ka = bf_lo(uk), kb = bf_hi(uk);
      float sk = wave_sum(ka * ka + kb * kb); float rk = rsqrtf(sk * (1.f / 128.f) + 1e-6f);
      bf16_t* ko = Kd + ((size_t)h * T + t) * 192;
      *(unsigned*)(ko + lane * 2) = cvt_pk_bf16(ka * rk * knn[lane * 2], kb * rk * knn[lane * 2 + 1]);
      ko[128 + lane] = (bf16_t)krv;
    }
  }
  bf16_t* tl = (bf16_t*)lds;
  for (int it = lbid(); it < 8 * (T / 64); it += gridDim.x) {
    const int h = it & 7, tb = it >> 3;
    __syncthreads();
    { const int tt = tid >> 3, dc = (tid & 7) * 16;
      const bf16_t* src = KVRAW + (size_t)(tb * 64 + tt) * 2048 + h * 256 + 128 + dc;
      *(u32x4*)(tl + tt * 136 + dc) = *(const u32x4*)src; *(u32x4*)(tl + tt * 136 + dc + 8) = *(const u32x4*)(src + 8); }
    __syncthreads();
    { const int dv = tid >> 2, tq = (tid & 3) * 16;
      unsigned o[8];
#pragma unroll
      for (int i = 0; i < 8; ++i) o[i] = (unsigned)tl[(tq + 2 * i) * 136 + dv] | ((unsigned)tl[(tq + 2 * i + 1) * 136 + dv] << 16);
      bf16_t* dst = VT + (((size_t)h * (T / 64) + tb) * 128 + dv) * 64 + tq;
      *(u32x4*)dst = (u32x4){o[0], o[1], o[2], o[3]}; *(u32x4*)(dst + 8) = (u32x4){o[4], o[5], o[6], o[7]}; }
  }
}

constexpr int SC_CH = 32, SC_STEP = 336, SC_STAGE = SC_CH * SC_STEP;
__device__ void scan_block(const Params& P, int sb, unsigned char* lds) {
  unsigned char* ws = P.ws;
  const float* LW = (const float*)(ws + A_LW); const float* LA = (const float*)(ws + A_LA); const float* VG = (const float*)(ws + A_VG);
  const float* KK = (const float*)(ws + A_KK); const bf16_t* KH = (const bf16_t*)(ws + A_KH); const bf16_t* R = (const bf16_t*)(ws + A_R);
  float* Y = (float*)(ws + A_YSC);
  float* buf = (float*)lds;
  const int head = sb >> 2, rg = sb & 3, tid = ltid();
  const bool loader = tid >= 256; const int lt = tid - 256;
  const int lane = tid & 63, wv = (tid >> 6) & 3, ks = lane & 15, myrow = wv * 4 + (lane >> 4);
  f32x4 S = {0.f, 0.f, 0.f, 0.f};
  const int hb = head * 64;
  struct Batch { f32x4 g0[2], g1[2], g2[2], gv; u32x4 h0, h1; };
  auto ld_chunk = [&](Batch& B, int c) {
    const int t0 = c * SC_CH;
#pragma unroll
    for (int i = 0; i < 2; ++i) { const int idx = lt + i * 256, st = idx >> 4, c4 = (idx & 15) * 4; const size_t o = (size_t)(t0 + st) * 1024 + hb + c4;
      B.g0[i] = *(const f32x4*)(LW + o); B.g1[i] = *(const f32x4*)(KK + o); B.g2[i] = *(const f32x4*)(LA + o); }
    { const int st = lt >> 3, c8 = (lt & 7) * 8; const size_t o = (size_t)(t0 + st) * 1024 + hb + c8; B.h0 = *(const u32x4*)(KH + o); B.h1 = *(const u32x4*)(R + o); }
    if (lt < 128) { const int st = lt >> 2, r4 = (lt & 3) * 4; B.gv = *(const f32x4*)(VG + (size_t)(t0 + st) * 1024 + hb + rg * 16 + r4); }
  };
  auto st_chunk = [&](const Batch& B, int s) {
    float* b = buf + s * SC_STAGE;
#pragma unroll
    for (int i = 0; i < 2; ++i) { const int idx = lt + i * 256, st = idx >> 4, c4 = (idx & 15) * 4; float* d = b + st * SC_STEP + c4;
      *(f32x4*)(d) = B.g0[i]; *(f32x4*)(d + 64) = B.g1[i]; *(f32x4*)(d + 128) = B.g2[i]; }
    { const int st = lt >> 3, c8 = (lt & 7) * 8; float* d = b + st * SC_STEP + c8;
      *(f32x4*)(d + 192) = (f32x4){bf_lo(B.h0.x), bf_hi(B.h0.x), bf_lo(B.h0.y), bf_hi(B.h0.y)}; *(f32x4*)(d + 196) = (f32x4){bf_lo(B.h0.z), bf_hi(B.h0.z), bf_lo(B.h0.w), bf_hi(B.h0.w)};
      *(f32x4*)(d + 256) = (f32x4){bf_lo(B.h1.x), bf_hi(B.h1.x), bf_lo(B.h1.y), bf_hi(B.h1.y)}; *(f32x4*)(d + 260) = (f32x4){bf_lo(B.h1.z), bf_hi(B.h1.z), bf_lo(B.h1.w), bf_hi(B.h1.w)}; }
    if (lt < 128) { const int st = lt >> 2, r4 = (lt & 3) * 4; *(f32x4*)(b + st * SC_STEP + 320 + r4) = B.gv; }
  };
  const int NCH = T / SC_CH;
  __syncthreads();
  if (loader) {
    Batch b0, b1, b2, b3;
    ld_chunk(b0, 0); st_chunk(b0, 0); ld_chunk(b1, 1); ld_chunk(b2, 2); ld_chunk(b3, 3); ld_chunk(b0, 4);
    __syncthreads();
    for (int c = 0; c < NCH; c += 4) {
      if (c + 1 < NCH) st_chunk(b1, (c + 1) & 1);
      if (c + 5 < NCH) ld_chunk(b1, c + 5);
      __syncthreads();
      if (c + 2 < NCH) st_chunk(b2, (c + 2) & 1);
      if (c + 6 < NCH) ld_chunk(b2, c + 6);
      __syncthreads();
      if (c + 3 < NCH) st_chunk(b3, (c + 3) & 1);
      if (c + 7 < NCH) ld_chunk(b3, c + 7);
      __syncthreads();
      if (c + 4 < NCH) st_chunk(b0, (c + 4) & 1);
      if (c + 8 < NCH) ld_chunk(b0, c + 8);
      __syncthreads();
    }
  } else {
    __builtin_amdgcn_s_setprio(2);
    __syncthreads();
    for (int c = 0; c < NCH; ++c) {
      const float* b = buf + (c & 1) * SC_STAGE;
      const float* q = b + ks * 4;
      const float* qv = b + 320 + myrow;
      float* yo = Y + (size_t)(c * SC_CH + ks) * 1024 + hb + rg * 16 + myrow;
      f32x4 w4 = *(const f32x4*)(q), k4 = *(const f32x4*)(q + 64), b4 = *(const f32x4*)(q + 128), kh4 = *(const f32x4*)(q + 192), r4 = *(const f32x4*)(q + 256);
      float v = qv[0];
      float yk = 0.f, ypart = 0.f;
#pragma unroll
      for (int s = 0; s < SC_CH; ++s) {
        f32x4 w4n, k4n, b4n, kh4n, r4n; float vn;
        if (s + 1 < SC_CH) {
          const float* qn = q + (s + 1) * SC_STEP;
          w4n = *(const f32x4*)(qn); k4n = *(const f32x4*)(qn + 64); b4n = *(const f32x4*)(qn + 128); kh4n = *(const f32x4*)(qn + 192); r4n = *(const f32x4*)(qn + 256);
          vn = qv[(s + 1) * SC_STEP];
        }
        __builtin_amdgcn_sched_barrier(0);
        if (s > 0) {
          const float y = dpp_allreduce16(ypart);
          yk = (ks == ((s - 1) & 15)) ? y : yk;
          if (((s - 1) & 15) == 15) yo[(size_t)(s - 16) * 1024] = yk;
        }
        const f32x2 pp = (f32x2){S[0], S[1]} * (f32x2){k4[0], k4[1]} + (f32x2){S[2], S[3]} * (f32x2){k4[2], k4[3]};
        const f32x4 A = S * w4 + v * kh4;
        const float ar = dpp_allreduce16(pp.x + pp.y);
        S = A + ar * b4;
        const f32x2 yy = (f32x2){S[0], S[1]} * (f32x2){r4[0], r4[1]} + (f32x2){S[2], S[3]} * (f32x2){r4[2], r4[3]};
        ypart = yy.x + yy.y;
        if (s + 1 < SC_CH) { w4 = w4n; k4 = k4n; b4 = b4n; kh4 = kh4n; r4 = r4n; v = vn; }
      }
      { const float y = dpp_allreduce16(ypart); yk = (ks == 15) ? y : yk; yo[(size_t)16 * 1024] = yk; }
      __syncthreads();
    }
    __builtin_amdgcn_s_setprio(0);
  }
}

constexpr int AT_KROW = 400, AT_VROW = 144, AT_K = 64 * AT_KROW, AT_STAGE = AT_K + 128 * AT_VROW;
__device__ void attn_block(const Params& P, int h, int qb, unsigned char* lds) {
  unsigned char* ws = P.ws;
  const bf16_t* Q = (const bf16_t*)(ws + A_Q); const bf16_t* Kd = (const bf16_t*)(ws + A_K); const bf16_t* VT = (const bf16_t*)(ws + A_VT);
  bf16_t* Y3 = (bf16_t*)(ws + A_Y3);
  const int tid = ltid(), w = tid >> 6, lane = tid & 63, fr = lane & 15, fq = lane >> 4;
  const int q0 = qb * 256, wq0 = q0 + w * 32;
  bf16x8 qf[2][6];
#pragma unroll
  for (int r2 = 0; r2 < 2; ++r2) {
    const bf16_t* qg = Q + ((size_t)h * T + wq0 + r2 * 16 + fr) * 192 + fq * 8;
#pragma unroll
    for (int kk = 0; kk < 6; ++kk) qf[r2][kk] = *(const bf16x8*)(qg + kk * 32);
  }
  f32x4 o[2][8];
#pragma unroll
  for (int r2 = 0; r2 < 2; ++r2)
#pragma unroll
    for (int n = 0; n < 8; ++n) o[r2][n] = (f32x4){0.f, 0.f, 0.f, 0.f};
  float m[2] = {-1e30f, -1e30f}, l[2] = {0.f, 0.f};
  const int ntiles = (q0 + 256) / 64;
  const bf16_t* Kh = Kd + (size_t)h * T * 192; const bf16_t* Vh = VT + (size_t)h * 128 * T;
  u32x4 kr[3], vr[2];
  auto ld_tile = [&](int kt) {
    const int k0 = kt * 64;
#pragma unroll
    for (int i = 0; i < 3; ++i) { const int c = tid + i * 512, row = c / 24, cc = c % 24; kr[i] = *(const u32x4*)(Kh + (size_t)(k0 + row) * 192 + cc * 8); }
#pragma unroll
    for (int i = 0; i < 2; ++i) { const int c = tid + i * 512; vr[i] = *(const u32x4*)(Vh + (size_t)kt * 8192 + c * 8); }
  };
  auto st_tile = [&](int s) {
    unsigned char* b = lds + s * AT_STAGE;
#pragma unroll
    for (int i = 0; i < 3; ++i) { const int c = tid + i * 512, row = c / 24, cc = c % 24; *(u32x4*)(b + row * AT_KROW + cc * 16) = kr[i]; }
#pragma unroll
    for (int i = 0; i < 2; ++i) { const int c = tid + i * 512, dv = c >> 3, cc = c & 7, x = dv & 31, row = (dv & ~31) + ((x >> 2) & 1) * 16 + (x >> 3) * 4 + (x & 3);
      *(u32x4*)(b + AT_K + row * AT_VROW + cc * 16) = vr[i]; }
  };
  __syncthreads();
  ld_tile(0); st_tile(0);
  __syncthreads();
  for (int kt = 0; kt < ntiles; ++kt) {
    const int k0 = kt * 64;
    if (kt + 1 < ntiles) ld_tile(kt + 1);
    if (k0 <= wq0 + 31) {
      const unsigned char* kb = lds + (kt & 1) * AT_STAGE; const unsigned char* vb = kb + AT_K;
      f32x4 s[2][4];
#pragma unroll
      for (int sub = 0; sub < 4; ++sub) {
        s[0][sub] = (f32x4){0.f, 0.f, 0.f, 0.f}; s[1][sub] = s[0][sub];
#pragma unroll
        for (int kk = 0; kk < 6; ++kk) {
          bf16x8 a = *(const bf16x8*)(kb + (sub * 16 + fr) * AT_KROW + (kk * 32 + fq * 8) * 2);
          s[0][sub] = __builtin_amdgcn_mfma_f32_16x16x32_bf16(a, qf[0][kk], s[0][sub], 0, 0, 0);
          s[1][sub] = __builtin_amdgcn_mfma_f32_16x16x32_bf16(a, qf[1][kk], s[1][sub], 0, 0, 0);
        }
      }
      u32x4 pk[2][2];
#pragma unroll
      for (int r2 = 0; r2 < 2; ++r2) {
        const int qrow = wq0 + r2 * 16 + fr;
        if (k0 + 63 > wq0 + r2 * 16) {
#pragma unroll
          for (int sub = 0; sub < 4; ++sub)
#pragma unroll
            for (int j = 0; j < 4; ++j) if (k0 + sub * 16 + fq * 4 + j > qrow) s[r2][sub][j] = -1e30f;
        }
        float mx = -1e30f;
#pragma unroll
        for (int sub = 0; sub < 4; ++sub)
#pragma unroll
          for (int j = 0; j < 4; ++j) mx = fmaxf(mx, s[r2][sub][j]);
        mx = xrow_max(mx);
        float mn = m[r2];
        if (__builtin_amdgcn_ballot_w64(mx - mn > 8.f) != 0ull) {
          mn = fmaxf(m[r2], mx);
          const float alpha = __builtin_amdgcn_exp2f(m[r2] - mn);
          m[r2] = mn; l[r2] *= alpha;
#pragma unroll
          for (int n = 0; n < 8; ++n) o[r2][n] *= alpha;
        }
        float ps = 0.f;
#pragma unroll
        for (int sub = 0; sub < 4; ++sub)
#pragma unroll
          for (int j = 0; j < 4; ++j) { s[r2][sub][j] = __builtin_amdgcn_exp2f(s[r2][sub][j] - mn); ps += s[r2][sub][j]; }
        l[r2] += ps;
#pragma unroll
        for (int kg = 0; kg < 2; ++kg) {
          pk[r2][kg].x = cvt_pk_bf16(s[r2][2 * kg][0], s[r2][2 * kg][1]); pk[r2][kg].y = cvt_pk_bf16(s[r2][2 * kg][2], s[r2][2 * kg][3]);
          pk[r2][kg].z = cvt_pk_bf16(s[r2][2 * kg + 1][0], s[r2][2 * kg + 1][1]); pk[r2][kg].w = cvt_pk_bf16(s[r2][2 * kg + 1][2], s[r2][2 * kg + 1][3]);
        }
      }
#pragma unroll
      for (int kg = 0; kg < 2; ++kg) {
        const bf16x8 pb0 = __builtin_bit_cast(bf16x8, pk[0][kg]), pb1 = __builtin_bit_cast(bf16x8, pk[1][kg]);
#pragma unroll
        for (int n = 0; n < 8; ++n) {
          const unsigned char* vp = vb + (n * 16 + fr) * AT_VROW + (kg * 32 + fq * 4) * 2;
          u32x2 v0 = *(const u32x2*)vp, v1 = *(const u32x2*)(vp + 32);
          const bf16x8 va = __builtin_bit_cast(bf16x8, ((u32x4){v0.x, v0.y, v1.x, v1.y}));
          o[0][n] = __builtin_amdgcn_mfma_f32_16x16x32_bf16(va, pb0, o[0][n], 0, 0, 0);
          o[1][n] = __builtin_amdgcn_mfma_f32_16x16x32_bf16(va, pb1, o[1][n], 0, 0, 0);
        }
      }
    }
    if (kt + 1 < ntiles) st_tile((kt + 1) & 1);
    __syncthreads();
  }
#pragma unroll
  for (int r2 = 0; r2 < 2; ++r2) {
    float lt = xrow_sum(l[r2]);
    const float inv = 1.f / lt;
    bf16_t* yo = Y3 + (size_t)(wq0 + r2 * 16 + fr) * 3072 + 1024 + h * 128 + fq * 8;
#pragma unroll
    for (int n = 0; n < 8; n += 2) *(u32x4*)(yo + (n >> 1) * 32) = pack8(o[r2][n] * inv, o[r2][n + 1] * inv);
  }
}

__device__ void sg_item(const Params& P, int l, int n, int g, unsigned char* lds) {
  unsigned char* ws = P.ws;
  const bf16_t* VN = (const bf16_t*)(ws + A_VN); const bf16_t* U = (const bf16_t*)(ws + A_U); const bf16_t* WS = (const bf16_t*)(ws + WT_SG);
  bf16_t* Y3 = (bf16_t*)(ws + A_Y3);
  const float* sb = (const float*)P.in[33] + (size_t)l * 1024 + g * 128;
  bf16_t* vt = (bf16_t*)lds;
  const int tid = ltid(), w = tid >> 6, lane = tid & 63, fr = lane & 15, fq = lane >> 4;
  __syncthreads();
#pragma unroll
  for (int i = 0; i < 4; ++i) {
    const int c = tid + i * 512, s = c >> 4, c8 = (c & 15) * 8;
    u32x4 v = *(const u32x4*)(VN + (size_t)(n * 128 + s) * 1024 + g * 128 + c8);
    const unsigned vv[4] = {v.x, v.y, v.z, v.w};
#pragma unroll
    for (int e = 0; e < 4; ++e) { vt[(c8 + 2 * e) * 136 + s] = (bf16_t)(vv[e] & 0xffff); vt[(c8 + 2 * e + 1) * 136 + s] = (bf16_t)(vv[e] >> 16); }
  }
  __syncthreads();
  const int trow = w * 16 + fr;
  bf16x8 wf[4];
  const bf16_t* wp = WS + ((size_t)g * 128 + trow) * 128 + fq * 8;
#pragma unroll
  for (int kk = 0; kk < 4; ++kk) wf[kk] = *(const bf16x8*)(wp + kk * 32);
  const int tt = n * 128 + trow;
  const float bias = sb[trow];
#pragma unroll
  for (int nn = 0; nn < 8; ++nn) {
    f32x4 acc = {0.f, 0.f, 0.f, 0.f};
#pragma unroll
    for (int kk = 0; kk < 4; ++kk) {
      bf16x8 b = *(const bf16x8*)(vt + (nn * 16 + fr) * 136 + kk * 32 + fq * 8);
      acc = __builtin_amdgcn_mfma_f32_16x16x32_bf16(b, wf[kk], acc, 0, 0, 0);
    }
    const int cc = g * 128 + nn * 16 + fq * 4;
    f32x4 u = ld_bf4(U + (size_t)tt * 1024 + cc);
    st_bf4(Y3 + (size_t)tt * 3072 + 2048 + cc, u * (acc + bias));
  }
}

__device__ void phase_post(const Params& P, int l) {
  unsigned char* ws = P.ws;
  const float* Y = (const float*)(ws + A_YSC); const float* VG = (const float*)(ws + A_VG);
  const bf16_t* KH = (const bf16_t*)(ws + A_KH); const bf16_t* R = (const bf16_t*)(ws + A_R); const bf16_t* LG = (const bf16_t*)(ws + A_LG);
  bf16_t* Y3 = (bf16_t*)(ws + A_Y3);
  const float* rk = (const float*)P.in[16] + l * 1024; const float* lw = (const float*)P.in[17] + l * 1024; const float* lb = (const float*)P.in[18] + l * 1024;
  const int wave = ltid() >> 6, lane = ltid() & 63;
  for (int t = lbid() * 8 + wave; t < T; t += gridDim.x * 8) {
#pragma unroll
    for (int i = 0; i < 4; ++i) {
      const int c = i * 256 + lane * 4; const size_t o = (size_t)t * 1024 + c;
      auto ntb = [](const bf16_t* p) { const u32x2 u = __builtin_nontemporal_load((const u32x2*)p); return (f32x4){bf_lo(u.x), bf_hi(u.x), bf_lo(u.y), bf_hi(u.y)}; };
      f32x4 y = __builtin_nontemporal_load((const f32x4*)(Y + o)), v = __builtin_nontemporal_load((const f32x4*)(VG + o)), r = ntb(R + o), kh = ntb(KH + o), g = ntb(LG + o);
      f32x4 rkv = *(const f32x4*)(rk + c);
      float s1 = sum16(y[0] + y[1] + y[2] + y[3]); const float mean = s1 * (1.f / 64.f);
      f32x4 d = y - mean;
      float s2 = sum16(d[0] * d[0] + d[1] * d[1] + d[2] * d[2] + d[3] * d[3]); const float rstd = rsqrtf(s2 * (1.f / 64.f) + 64e-5f);
      float bs = sum16(r[0] * kh[0] * rkv[0] + r[1] * kh[1] * rkv[1] + r[2] * kh[2] * rkv[2] + r[3] * kh[3] * rkv[3]);
      f32x4 out = (d * rstd * *(const f32x4*)(lw + c) + *(const f32x4*)(lb + c) + bs * v) * g;
      st_bf4(Y3 + (size_t)t * 3072 + c, out);
    }
  }
}

__device__ void phase_conv(const Params& P, int l) {
  unsigned char* ws = P.ws;
  const bf16_t* UP = (const bf16_t*)(ws + A_UP); bf16_t* ACT = (bf16_t*)(ws + A_ACT);
  const float* cw = (const float*)P.in[39] + (size_t)l * 3 * 11264; const float* cb = (const float*)P.in[40] + (size_t)l * 11264;
  const int tid = ltid(), wave = tid >> 6, lane = tid & 63;
  constexpr int RC = 32, NCG = DFF / 256;
  const f32x4 z4 = {0.f, 0.f, 0.f, 0.f};
  for (int item = lbid() * 8 + wave; item < (T / RC) * NCG; item += gridDim.x * 8) {
    const int cg = item % NCG, t0 = (item / NCG) * RC;
    const int j = (cg * 64 + lane) * 4;
    const f32x4 wg0 = *(const f32x4*)(cw + j), wg1 = *(const f32x4*)(cw + 11264 + j), wg2 = *(const f32x4*)(cw + 2 * 11264 + j), bg = *(const f32x4*)(cb + j);
    const f32x4 wv0 = *(const f32x4*)(cw + DFF + j), wv1 = *(const f32x4*)(cw + 11264 + DFF + j), wv2 = *(const f32x4*)(cw + 2 * 11264 + DFF + j), bv = *(const f32x4*)(cb + DFF + j);
    const bf16_t* up = UP + (size_t)t0 * 11264 + j;
    f32x4 g1 = t0 >= 1 ? ld_bf4(up - 11264) : z4, g2 = t0 >= 2 ? ld_bf4(up - 2 * 11264) : z4;
    f32x4 v1 = t0 >= 1 ? ld_bf4(up - 11264 + DFF) : z4, v2 = t0 >= 2 ? ld_bf4(up - 2 * 11264 + DFF) : z4;
    bf16_t* ao = ACT + (size_t)t0 * DFF + j;
#pragma unroll 8
    for (int t = 0; t < RC; ++t) {
      const u32x2 gr = __builtin_nontemporal_load((const u32x2*)(up + (size_t)t * 11264)), vr = __builtin_nontemporal_load((const u32x2*)(up + (size_t)t * 11264 + DFF));
      const f32x4 g0 = {bf_lo(gr.x), bf_hi(gr.x), bf_lo(gr.y), bf_hi(gr.y)}, v0 = {bf_lo(vr.x), bf_hi(vr.x), bf_lo(vr.y), bf_hi(vr.y)};
      const f32x4 cgv = bg + wg2 * g0 + wg1 * g1 + wg0 * g2;
      const f32x4 cvv = bv + wv2 * v0 + wv1 * v1 + wv0 * v2;
      f32x4 o;
#pragma unroll
      for (int e = 0; e < 4; ++e) o[e] = cgv[e] * sigmoidf_(cgv[e]) * cvv[e];
      st_bf4(ao + (size_t)t * DFF, o);
      g2 = g1; g1 = g0; v2 = v1; v1 = v0;
    }
  }
}

constexpr int NPL = 14, NPH = 1 + NL * NPL;
DEVI int phase_njobs(int pl, int l) {
  switch (pl) { case 1: return 1; case 3: return l > 0 ? 6 : 5; case 4: return l > 0 ? 1 : 0; case 6: return 1; case 8: return 1; case 9: return 1; case 11: return 1; case 13: return 1; default: return 0; }
}
DEVI GJob get_job(const Params& P, int pl, int l, int j) {
  unsigned char* ws = P.ws; GJob g{}; g.keep = 0;
  const float* mod = (const float*)(ws + WS_MOD) + l * 12288;
  switch (pl) {
    case 1: g.A = (const bf16_t*)(ws + A_H); g.lda = 2048; g.Bt = (const bf16_t*)(ws + WT_IN + (size_t)(l & 1) * WTIN_BYTES); g.ldb = 2048; g.N = PW; g.K = 2048; g.mode = 0; g.out = ws + A_P; g.ldo = PW; break;
    case 3:
      if (j == 0) { g.A = (const bf16_t*)(ws + A_QL); g.lda = 512; g.Bt = (const bf16_t*)(ws + WT_UQ); g.ldb = 512; g.N = 1536; g.K = 512; g.mode = 0; g.out = ws + A_QRAW; g.ldo = 1536; }
      else if (j == 1) { g.A = (const bf16_t*)(ws + A_CKV); g.lda = 512; g.Bt = (const bf16_t*)(ws + WT_UKV); g.ldb = 512; g.N = 2048; g.K = 512; g.mode = 0; g.out = ws + A_KVRAW; g.ldo = 2048; }
      else if (j == 2) { g.A = (const bf16_t*)(ws + A_AL); g.lda = 768; g.Bt = (const bf16_t*)(ws + WT_LW); g.ldb = 256; g.N = 1024; g.K = 256; g.mode = 1; g.out = ws + A_LW; g.ldo = 1024; }
      else if (j == 3) { g.A = (const bf16_t*)(ws + A_AL) + 256; g.lda = 768; g.Bt = (const bf16_t*)(ws + WT_LA); g.ldb = 256; g.N = 1024; g.K = 256; g.mode = 1; g.out = ws + A_LA; g.ldo = 1024; }
      else if (j == 4) { g.A = (const bf16_t*)(ws + A_AL) + 512; g.lda = 768; g.Bt = (const bf16_t*)(ws + WT_LG); g.ldb = 256; g.N = 1024; g.K = 256; g.mode = 0; g.out = ws + A_LG; g.ldo = 1024; }
      else { g.A = (const bf16_t*)(ws + A_VB); g.lda = 1024; g.Bt = (const bf16_t*)(ws + WT_V1); g.ldb = 1024; g.N = 256; g.K = 1024; g.mode = 0; g.out = ws + A_VL; g.ldo = 256; }
      break;
    case 4: g.A = (const bf16_t*)(ws + A_VL); g.lda = 256; g.Bt = (const bf16_t*)(ws + WT_V2); g.ldb = 256; g.N = 1024; g.K = 256; g.mode = 1; g.out = ws + A_VG; g.ldo = 1024; break;
    case 6: g.A = (const bf16_t*)(ws + A_H); g.lda = 2048; g.Bt = (const bf16_t*)(ws + WT_IN + (size_t)(l & 1) * WTIN_BYTES) + (size_t)PW * 2048; g.ldb = 2048; g.N = NGATE; g.K = 2048; g.mode = 2; g.out = ws + A_GATE; g.ldo = NGATE; break;
    case 8: g.A = (const bf16_t*)(ws + A_Y3); g.lda = 3072; g.Bt = (const bf16_t*)(ws + WT_BR); g.ldb = 3072; g.N = 2048; g.K = 3072; g.mode = 7;
            g.out = ws + A_MERG; g.aux = ws + A_GATE; g.ldo = 2048; break;
    case 9: g.A = (const bf16_t*)(ws + A_MERG); g.lda = 2048; g.Bt = (const bf16_t*)(ws + WT_OUT); g.ldb = 2048; g.N = 2048; g.K = 2048; g.mode = 6;
            g.out = ws + WS_X; g.aux = (l == 0) ? P.in[0] : (const void*)(ws + WS_X); g.aux2 = mod + 2 * 2048; g.ldo = 2048; break;
    case 11: g.A = (const bf16_t*)(ws + A_H); g.lda = 2048; g.Bt = (const bf16_t*)(ws + WT_UP); g.ldb = 2048; g.N = 11264; g.K = 2048; g.mode = 0; g.out = ws + A_UP; g.ldo = 11264; break;
    default: g.A = (const bf16_t*)(ws + A_ACT); g.lda = DFF; g.Bt = (const bf16_t*)(ws + WT_DN); g.ldb = DFF; g.N = 2048; g.K = DFF; g.mode = 6;
            g.out = (l == NL - 1) ? (void*)P.out : (void*)(ws + WS_X); g.aux = ws + WS_X; g.aux2 = mod + 5 * 2048; g.ldo = 2048; break;
  }
  g.A = (const bf16_t*)uptr(g.A); g.Bt = (const bf16_t*)uptr(g.Bt); g.out = (void*)uptr(g.out); g.aux = uptr(g.aux); g.aux2 = uptr(g.aux2);
  g.lda = __builtin_amdgcn_readfirstlane(g.lda); g.ldb = __builtin_amdgcn_readfirstlane(g.ldb); g.ldo = __builtin_amdgcn_readfirstlane(g.ldo);
  g.N = __builtin_amdgcn_readfirstlane(g.N); g.K = __builtin_amdgcn_readfirstlane(g.K); g.mode = __builtin_amdgcn_readfirstlane(g.mode); g.keep = __builtin_amdgcn_readfirstlane(g.keep);
  return g;
}

__global__ void __launch_bounds__(512) fwd_kernel(Params Parg) {
  extern __shared__ __attribute__((aligned(16))) unsigned char lds[];
  cg::grid_group grid = cg::this_grid();
  const int ph_lo = Parg.ph_lo, ph_hi = Parg.ph_hi;
  __shared__ uint4 xb_words;
  if (__builtin_amdgcn_workitem_id_x() == 0) xb_words = make_uint4(0u, 0u, 0u, 0u);
  __syncthreads();
  XcdBarrier xb = xcd_barrier_post((unsigned*)(Parg.ws + WS_BAR), (volatile LAS unsigned*)&xb_words);
  for (int ph = ph_lo; ph < ph_hi; ++ph) {
    const __attribute__((address_space(4))) Params* pp = (const __attribute__((address_space(4))) Params*)__builtin_amdgcn_kernarg_segment_ptr();
    asm volatile("" : "+s"(pp));
    const Params& P = *(const Params*)pp;
    unsigned char* ws = P.ws;
    int l = 0, pl = -1;
    if (ph > 0) { l = (ph - 1) / NPL; pl = (ph - 1) % NPL; }
    const float* mod = (const float*)(ws + WS_MOD) + l * 12288;
    const int nrep = ((ph > 0 && ((PROBE_MASK >> pl) & 1)) || (ph == 0 && ((PROBE_MASK >> 30) & 1))) ? 2 : 1;
    for (int rep = 0; rep < nrep; ++rep) {
    int c = lbid(), G = gridDim.x;
    if (ph == 0) { if (EN_INIT) phase_init(P, lds); }
    else switch (pl) {
      case 0: {
        const float* xin = (l == 0) ? (const float*)P.in[0] : (const float*)(ws + WS_X);
        if (EN_MISC) phase_h(xin, (const float*)P.in[5] + l * D, mod, mod + 2048, (bf16_t*)(ws + A_H));
      } break;
      case 2: if (EN_PREP) phase_prep1(P, l); break;
      case 5: if (EN_PREP) phase_prep2(P, l, lds); break;
      case 6: {
        if ((int)lbid() < NSCAN) { if (EN_SCAN && (rep == 0 || (PROBE_PART & 1))) scan_block(P, lbid(), lds); c = -1; }
        else {
          c = lbid() - NSCAN; G = gridDim.x - NSCAN;
          __syncthreads();
        }
      } break;
      case 7: if (EN_MISC) phase_post(P, l); break;
      case 10: if (EN_MISC) phase_h((const float*)(ws + WS_X), (const float*)P.in[6] + l * D, mod + 3 * 2048, mod + 4 * 2048, (bf16_t*)(ws + A_H)); break;
      case 12: if (EN_MISC) phase_conv(P, l); break;
      default: break;
    }
    {
      constexpr unsigned CM_IN = 0x1Fu, CM_SMALL = 0xFE0u, CM_LATE = 0x3F000u, CM_SG = 1u << 18;
      unsigned cm0 = 0, cm1 = 0; int cl1 = l + 1;
      int cc = c, cG = G;
      const int slot = (c & 7) * (G >> 3) + (c >> 3);
      if (ph == 0) cm0 = CM_IN | CM_SMALL | CM_SG;
      else if (pl == 1 && rep == 0) { cm0 = (1u << 15) | (1u << 16); cc = slot - 96; cG = 160; }
      else if (pl == 11 && l + 1 < NL && rep == 0) { cm1 = CM_IN | CM_SMALL | CM_SG; cc = slot - 128; cG = 128; }
      else if (pl == 6 && c >= 0 && (rep == 0 || (PROBE_PART & 16))) cm0 = (7u << 12) | (1u << 17);
      for (int k = 0; k < 2; ++k) { const unsigned m = k ? cm1 : cm0; if (m && EN_INIT && cc >= 0) convert_layer(P, k ? cl1 : l, m, cc, cG, lds); }
    }
    if (ph > 0) {
      const int nj = phase_njobs(pl, l);
      int cursor = 0;
      for (int j = 0; j < nj; ++j) { GJob jb = get_job(P, pl, l, j); if (EN_GEMM && (pl != 6 || rep == 0 || (PROBE_PART & 8))) gemm_job(jb, cursor, c, G, lds); }
    }
    if (ph > 0 && pl == 6 && c >= 0) {
      if (EN_ATTN && (rep == 0 || (PROBE_PART & 2))) {
        unsigned* qctr = (unsigned*)(ws + WS_BAR) + 3600 + (l * 2 + rep) * 64;
        volatile int* slot = (volatile int*)(lds + 131056);
        for (;;) {
          __syncthreads();
          if (ltid() == 0) *slot = (int)atomicAdd(qctr, 1u);
          __syncthreads();
          const int idx = *slot;
          if (idx >= 256) break;
          attn_block(P, idx & 7, 31 - (idx >> 3), lds);
        }
      }
      for (int it = c; it < 512; it += G) if (EN_SG && (rep == 0 || (PROBE_PART & 4))) sg_item(P, l, it >> 3, it & 7, lds);
      __syncthreads();
    }
    }
    if (ph_hi > 100000) grid.sync();
    if (ph + 1 < ph_hi && !(pl == 4 && l == 0)) xcd_barrier(xb);
  }
}

extern "C" void kernel_launch(void* const* d_in, const int* in_sizes, int n_in, void* d_out, int out_size, void* d_ws, size_t ws_size, hipStream_t stream) {
  static int grid = 0;
  if (grid == 0) {
    if (n_in != 42 || ws_size < WS_END) { fprintf(stderr, "kernel_launch: unexpected n_in %d / ws %zu (need %zu)\n", n_in, ws_size, (size_t)WS_END); grid = -1; return; }
    int dev = 0, cus = 0, per_cu = 0;
    hipGetDevice(&dev);
    hipDeviceGetAttribute(&cus, hipDeviceAttributeMultiprocessorCount, dev);
    if (hipFuncSetAttribute((const void*)fwd_kernel, hipFuncAttributeMaxDynamicSharedMemorySize, LDS_BYTES) != hipSuccess) { fprintf(stderr, "kernel_launch: hipFuncSetAttribute failed\n"); grid = -1; return; }
    hipOccupancyMaxActiveBlocksPerMultiprocessor(&per_cu, (const void*)fwd_kernel, 512, LDS_BYTES);
    if (per_cu < 1) { fprintf(stderr, "kernel_launch: occupancy query returned %d\n", per_cu); per_cu = 1; }
    (void)hipGetLastError();
    grid = cus;
  }
  if (grid < 0) return;
  Params p{};
  for (int i = 0; i < 42; ++i) p.in[i] = d_in[i];
  p.out = (float*)d_out; p.ws = (unsigned char*)d_ws;
  if (hipMemsetAsync((char*)d_ws + WS_MOD, 0, WS_BAR + 16384 - WS_MOD, stream) != hipSuccess)
#if N_LAUNCH_MODE == 1
  p.ph_lo = 0; p.ph_hi = NPH;
  void* args[] = {&p};
  hipError_t e = hipLaunchCooperativeKernel((const void*)fwd_kernel, dim3(grid), dim3(512), args, LDS_BYTES, stream);
  if (e != hipSuccess) fprintf(stderr, "cooperative launch failed: %s (grid %d)\n", hipGetErrorString(e), grid);
#else
  for (int ph = 0; ph < NPH; ++ph) {
    p.ph_lo = ph; p.ph_hi = ph + 1;
    hipLaunchKernelGGL(fwd_kernel, dim3(grid), dim3(512), LDS_BYTES, stream, p);
  }
#endif
}
```

```cpp
#include <hip/hip_runtime.h>
#include <hip/hip_cooperative_groups.h>
#include <cstdio>
namespace cg = cooperative_groups;

#ifndef EN_MISC
#define EN_MISC 1
#endif
#ifndef EN_INIT
#define EN_INIT 1
#endif
#ifndef EN_PREP
#define EN_PREP 1
#endif
#ifndef EN_SCAN
#define EN_SCAN 1
#endif
#ifndef EN_ATTN
#define EN_ATTN 1
#endif
#ifndef EN_SG
#define EN_SG 1
#endif
#ifndef EN_GEMM
#define EN_GEMM 1
#endif
#ifndef PROBE_MASK
#define PROBE_MASK 0
#endif
#ifndef PROBE_PART
#define PROBE_PART 0
#endif
#ifndef N_LAUNCH_MODE
#define N_LAUNCH_MODE 1
#endif

typedef unsigned short bf16_t;
typedef short bf16x8 __attribute__((ext_vector_type(8)));
typedef float f32x4 __attribute__((ext_vector_type(4)));
typedef float f32x2 __attribute__((ext_vector_type(2)));
typedef unsigned u32x4 __attribute__((ext_vector_type(4)));
typedef unsigned u32x2 __attribute__((ext_vector_type(2)));
#define DEVI __device__ __forceinline__

constexpr int T = 8192, D = 2048, NL = 2;
constexpr int NIN = 12800;
constexpr int PW = 6912;
constexpr int PC_DQ = 3584, PC_CKV = 4096, PC_KR = 4608, PC_U = 4864, PC_VS = 5888;
constexpr int NGATE = 6144;
constexpr int DFF = 5632;
constexpr int NSCAN = 64;

constexpr size_t al256(size_t x) { return (x + 255) & ~(size_t)255; }
constexpr size_t WS_MOD = 0;
constexpr size_t WS_BAR = al256(WS_MOD + (size_t)NL * 6 * D * 4);
constexpr size_t WS_COS = WS_BAR + 16384;
constexpr size_t WS_SIN = WS_COS + (size_t)T * 32 * 4;
constexpr size_t WS_X   = WS_SIN + (size_t)T * 32 * 4;
constexpr size_t WS_VF  = WS_X + (size_t)T * D * 4;
constexpr size_t WT_IN  = WS_VF + (size_t)T * 1024 * 4;
constexpr size_t WTIN_BYTES = (size_t)13056 * 2048 * 2;
constexpr size_t WT_UQ  = WT_IN + 2 * WTIN_BYTES;
constexpr size_t WT_UKV = WT_UQ + (size_t)1536 * 512 * 2;
constexpr size_t WT_LW  = WT_UKV + (size_t)2048 * 512 * 2;
constexpr size_t WT_LA  = WT_LW + (size_t)1024 * 256 * 2;
constexpr size_t WT_LG  = WT_LA + (size_t)1024 * 256 * 2;
constexpr size_t WT_V1  = WT_LG + (size_t)1024 * 256 * 2;
constexpr size_t WT_V2  = WT_V1 + (size_t)256 * 1024 * 2;
constexpr size_t WT_BR  = WT_V2 + (size_t)1024 * 256 * 2;
constexpr size_t WT_OUT = WT_BR + (size_t)3 * 2048 * 1024 * 2;
constexpr size_t WT_UP  = WT_OUT + (size_t)2048 * 2048 * 2;
constexpr size_t WT_DN  = WT_UP + (size_t)11264 * 2048 * 2;
constexpr size_t WT_SG  = WT_DN + (size_t)2048 * 5632 * 2;
constexpr size_t A_H    = WT_SG + (size_t)8 * 128 * 128 * 2;
constexpr size_t A_P    = A_H + (size_t)T * 2048 * 2;
constexpr size_t A_GATE = A_P;
constexpr size_t A_LW   = A_P + (size_t)T * PW * 2;
constexpr size_t A_LA   = A_LW + (size_t)T * 1024 * 4;
constexpr size_t A_VG   = A_LA + (size_t)T * 1024 * 4;
constexpr size_t A_MACC = A_LW;
constexpr size_t A_MERG = A_VG;
constexpr size_t A_LG   = A_VG + (size_t)T * 1024 * 4;
constexpr size_t A_VL   = A_LG + (size_t)T * 1024 * 2;
constexpr size_t A_QRAW = A_VL + (size_t)T * 256 * 2;
constexpr size_t A_KVRAW= A_QRAW + (size_t)T * 1536 * 2;
constexpr size_t A_AL   = A_KVRAW + (size_t)T * 2048 * 2;
constexpr size_t A_VB   = A_AL + (size_t)T * 768 * 2;
constexpr size_t A_YSC  = A_QRAW;
constexpr size_t A_Y3   = A_YSC + (size_t)T * 1024 * 4;
constexpr size_t A_QL   = A_VB + (size_t)T * 1024 * 2;
constexpr size_t A_CKV  = A_QL + (size_t)T * 512 * 2;
constexpr size_t A_KR   = A_CKV + (size_t)T * 512 * 2;
constexpr size_t A_U    = A_KR + (size_t)T * 64 * 2;
constexpr size_t A_VN   = A_U + (size_t)T * 1024 * 2;
constexpr size_t A_KK   = A_VN + (size_t)T * 1024 * 2;
constexpr size_t A_KH   = A_KK + (size_t)T * 1024 * 4;
constexpr size_t A_R    = A_KH + (size_t)T * 1024 * 2;
constexpr size_t A_Q    = A_R + (size_t)T * 1024 * 2;
constexpr size_t A_K    = A_Q + (size_t)8 * T * 192 * 2;
constexpr size_t A_VT   = A_K + (size_t)8 * T * 192 * 2;
constexpr size_t WS_END = A_VT + (size_t)8 * 128 * T * 2;
constexpr size_t A_UP   = A_P;
constexpr size_t A_ACT  = A_UP + (size_t)T * 11264 * 2;
static_assert(A_Y3 + (size_t)T * 3072 * 2 <= A_QL, "alias overflow");
static_assert(A_ACT + (size_t)T * DFF * 2 <= WS_END, "ffn alias overflow");
static_assert(WS_END < 858000000ull, "workspace too large");

constexpr int LDS_BYTES = 131072;

struct Params {
  const void* in[42];
  float* out;
  unsigned char* ws;
  int ph_lo, ph_hi;
};

DEVI int lbid() { int t = __builtin_amdgcn_workgroup_id_x(); asm volatile("" : "+s"(t)); return t; }
DEVI const void* uptr(const void* p) { unsigned long long v = (unsigned long long)p; unsigned lo = __builtin_amdgcn_readfirstlane((unsigned)v), hi = __builtin_amdgcn_readfirstlane((unsigned)(v >> 32)); return (const void*)(((unsigned long long)hi << 32) | lo); }
DEVI int ltid() { int t = __builtin_amdgcn_workitem_id_x(); asm volatile("" : "+v"(t)); return t; }
DEVI unsigned cvt_pk_bf16(float lo, float hi) { unsigned r; asm("v_cvt_pk_bf16_f32 %0, %1, %2" : "=v"(r) : "v"(lo), "v"(hi)); return r; }
DEVI float bf_lo(unsigned u) { return __uint_as_float(u << 16); }
DEVI float bf_hi(unsigned u) { return __uint_as_float(u & 0xffff0000u); }
DEVI float bf2f(bf16_t h) { return __uint_as_float(((unsigned)h) << 16); }
DEVI bf16_t f2bf(float f) { return (bf16_t)(cvt_pk_bf16(f, 0.f) & 0xffffu); }
DEVI float sigmoidf_(float x) { return 1.f / (1.f + __expf(-x)); }
DEVI float tanhf_(float x) { x = fminf(fmaxf(x, -15.f), 15.f); float t = __expf(2.f * x); return (t - 1.f) / (t + 1.f); }
DEVI float geluf_(float x) { return 0.5f * x * (1.f + tanhf_(0.7978845608028654f * (x + 0.044715f * x * x * x))); }
DEVI float wave_sum(float v) {
#pragma unroll
  for (int o = 32; o > 0; o >>= 1) v += __shfl_xor(v, o);
  return v;
}
DEVI float sum16(float v) {
#pragma unroll
  for (int o = 8; o > 0; o >>= 1) v += __shfl_xor(v, o);
  return v;
}
DEVI float dpp_allreduce16(float x) {
  x += __builtin_bit_cast(float, __builtin_amdgcn_update_dpp(0, __builtin_bit_cast(int, x), 0xB1, 0xF, 0xF, true));
  x += __builtin_bit_cast(float, __builtin_amdgcn_update_dpp(0, __builtin_bit_cast(int, x), 0x4E, 0xF, 0xF, true));
  x += __builtin_bit_cast(float, __builtin_amdgcn_update_dpp(0, __builtin_bit_cast(int, x), 0x141, 0xF, 0xF, true));
  x += __builtin_bit_cast(float, __builtin_amdgcn_update_dpp(0, __builtin_bit_cast(int, x), 0x140, 0xF, 0xF, true));
  return x;
}
DEVI float xrow_max(float x) {
  auto a = __builtin_amdgcn_permlane16_swap(__float_as_uint(x), __float_as_uint(x), false, false);
  float m1 = fmaxf(__uint_as_float(a[0]), __uint_as_float(a[1]));
  auto b = __builtin_amdgcn_permlane32_swap(__float_as_uint(m1), __float_as_uint(m1), false, false);
  return fmaxf(__uint_as_float(b[0]), __uint_as_float(b[1]));
}
DEVI float xrow_sum(float x) {
  auto a = __builtin_amdgcn_permlane16_swap(__float_as_uint(x), __float_as_uint(x), false, false);
  float m1 = __uint_as_float(a[0]) + __uint_as_float(a[1]);
  auto b = __builtin_amdgcn_permlane32_swap(__float_as_uint(m1), __float_as_uint(m1), false, false);
  return __uint_as_float(b[0]) + __uint_as_float(b[1]);
}
DEVI f32x4 ld_bf4(const bf16_t* p) { u32x2 u = *(const u32x2*)p; return (f32x4){bf_lo(u.x), bf_hi(u.x), bf_lo(u.y), bf_hi(u.y)}; }
DEVI void st_bf4(bf16_t* p, f32x4 v) { u32x2 u; u.x = cvt_pk_bf16(v[0], v[1]); u.y = cvt_pk_bf16(v[2], v[3]); *(u32x2*)p = u; }


#define XB_TMO      128
#define XB_XCNT(j)  (256  + 64 * (j))
#define XB_XSUB(j)  (1280 + 64 * (j))
#define XB_XGEN(j)  (2304 + 64 * (j))
#define XB_TOP      3328
#define XB_TOPGEN   3392
#define XCD_BAR_WORDS 3456
#define XB_SPIN_CAP (1u << 20)
#define LAS __attribute__((address_space(3)))
DEVI unsigned xb_ld(unsigned* p) { return __hip_atomic_load(p, __ATOMIC_RELAXED, __HIP_MEMORY_SCOPE_AGENT); }
DEVI unsigned xb_add(unsigned* p, unsigned v) { return __hip_atomic_fetch_add(p, v, __ATOMIC_RELAXED, __HIP_MEMORY_SCOPE_AGENT); }
DEVI unsigned xb_xcc_id() { return (unsigned)__builtin_amdgcn_s_getreg((3 << 11) | 20) & 0xFu; }
#define XB_SPIN(cond, bar) do { unsigned _sp = 0; while (cond) { __builtin_amdgcn_s_sleep(4); \
    if ((++_sp & 255u) == 0u) { if (xb_ld(&(bar)[XB_TMO])) break; if (_sp > XB_SPIN_CAP) { atomicAdd(&(bar)[XB_TMO], 1u); break; } } } } while (0)
struct XcdBarrier { unsigned* bar; unsigned x; volatile LAS unsigned* st; };
DEVI XcdBarrier xcd_barrier_post(unsigned* bar, volatile LAS unsigned* st) {
  XcdBarrier b; b.bar = bar; b.x = xb_xcc_id(); b.st = st;
  if (__builtin_amdgcn_workitem_id_x() == 0) (void)xb_add(&bar[XB_XCNT(b.x)], 1u);
  return b;
}
DEVI void xcd_barrier_complete(unsigned* bar, unsigned x, unsigned& nloc, unsigned& nx) {
  const unsigned G = gridDim.x;
  unsigned sum, cnt, mine, sp = 0u;
  for (;;) {
    sum = 0u; cnt = 0u; mine = 0u;
#pragma unroll
    for (unsigned j = 0; j < 16; ++j) { const unsigned c = xb_ld(&bar[XB_XCNT(j)]); sum += c; cnt += (c > 0u) ? 1u : 0u; mine = (j == x) ? c : mine; }
    if (sum == G) break;
    __builtin_amdgcn_s_sleep(1);
    if ((++sp & 255u) == 0u) { if (xb_ld(&bar[XB_TMO])) break; if (sp > XB_SPIN_CAP) { atomicAdd(&bar[XB_TMO], 1u); break; } }
  }
  nloc = mine > 0u ? mine : 1u; nx = cnt > 0u ? cnt : 1u;
}
DEVI void xcd_barrier(const XcdBarrier& b) {
  asm volatile("s_waitcnt vmcnt(0)" ::: "memory");
  __syncthreads();
  if (__builtin_amdgcn_workitem_id_x() == 0) {
    unsigned* bar = b.bar;
    __builtin_amdgcn_s_waitcnt(0);
    unsigned nloc = b.st[0], nx = b.st[1];
    if (nloc == 0u) { xcd_barrier_complete(bar, b.x, nloc, nx); b.st[0] = nloc; b.st[1] = nx; }
    const unsigned old = xb_add(&bar[XB_XSUB(b.x)], 1u);
    const unsigned gen = old / nloc;
    if (old + 1u == (gen + 1u) * nloc) {
      __builtin_amdgcn_fence(__ATOMIC_RELEASE, "agent");
      asm volatile("s_waitcnt vmcnt(0)" ::: "memory");
      const unsigned og = xb_add(&bar[XB_TOP], 1u);
      const unsigned tg = og / nx;
      if (og + 1u == (tg + 1u) * nx) xb_add(&bar[XB_TOPGEN], 1u);
      else XB_SPIN(xb_ld(&bar[XB_TOPGEN]) == tg, bar);
      __builtin_amdgcn_fence(__ATOMIC_ACQUIRE, "agent");
      xb_add(&bar[XB_XGEN(b.x)], 1u);
      asm volatile("s_waitcnt vmcnt(0)" ::: "memory");
    } else {
      XB_SPIN(xb_ld(&bar[XB_XGEN(b.x)]) == gen, bar);
      __builtin_amdgcn_fence(__ATOMIC_ACQUIRE, "agent");
      asm volatile("s_waitcnt vmcnt(0)" ::: "memory");
    }
  }
  __syncthreads();
}

constexpr int BM = 256, BK = 64, HALF = 128, HT = HALF * BK, WGM = 8;
struct GJob { const bf16_t* A; const bf16_t* Bt; void* out; const void* aux; const void* aux2; int lda, ldb, ldo, N, K, mode, keep; };

DEVI int lds_byte(int r, int c) { int st = (r >> 4) * 2 + (c >> 5), rr = r & 15, cc = c & 31, ob = rr * 64 + cc * 2; return st * 1024 + (ob ^ (((ob >> 9) & 1) << 5)); }
DEVI void stage_rc(int b, int& R, int& C) { int st = b >> 10, sb = b & 1023, swz = sb ^ (((sb >> 9) & 1) << 5); R = (st >> 1) * 16 + (swz >> 6); C = (st & 1) * 32 + ((swz & 63) >> 1); }

DEVI int perm32(int rho) { const int n = rho >> 4, i = rho & 15; return 8 * (i >> 2) + 4 * n + (i & 3); }
DEVI u32x4 pack8(f32x4 a, f32x4 b) { u32x4 o; o.x = cvt_pk_bf16(a[0], a[1]); o.y = cvt_pk_bf16(a[2], a[3]); o.z = cvt_pk_bf16(b[0], b[1]); o.w = cvt_pk_bf16(b[2], b[3]); return o; }
DEVI void gemm_epi(const GJob& jb, int row, int col, f32x4 v0, f32x4 v1) {
  const int mode = jb.mode;
  if (mode == 0) { *(u32x4*)((bf16_t*)jb.out + (size_t)row * jb.ldo + col) = pack8(v0, v1); }
  else if (mode == 1) { float* p = (float*)jb.out + (size_t)row * jb.ldo + col; *(f32x4*)p = v0; *(f32x4*)(p + 4) = v1; }
  else if (mode == 2) { f32x4 s0, s1; for (int i = 0; i < 4; ++i) { s0[i] = sigmoidf_(v0[i]); s1[i] = sigmoidf_(v1[i]); } *(u32x4*)((bf16_t*)jb.out + (size_t)row * jb.ldo + col) = pack8(s0, s1); }
  else if (mode == 7) {
    const u32x4 g = *(const u32x4*)((const bf16_t*)jb.aux + (size_t)row * NGATE + 2 * 2048 + col);
    const f32x4 g0 = {bf_lo(g.x), bf_hi(g.x), bf_lo(g.y), bf_hi(g.y)}, g1 = {bf_lo(g.z), bf_hi(g.z), bf_lo(g.w), bf_hi(g.w)};
    *(u32x4*)((bf16_t*)jb.out + (size_t)row * 2048 + col) = pack8(g0 * v0, g1 * v1);
  } else {
    const float* xp = (const float*)jb.aux + (size_t)row * jb.ldo + col; const float* gp = (const float*)jb.aux2 + col;
    float* op = (float*)jb.out + (size_t)row * jb.ldo + col;
    const f32x4 x0 = *(const f32x4*)xp, x1 = *(const f32x4*)(xp + 4), t0 = *(const f32x4*)gp, t1 = *(const f32x4*)(gp + 4);
    *(f32x4*)op = x0 + t0 * v0; *(f32x4*)(op + 4) = x1 + t1 * v1;
  }
}

DEVI void gemm_tile(const GJob& jb, int brow, int bcol, unsigned char* shm_) {
  LAS unsigned char* lds = (LAS unsigned char*)shm_;
  const int lda = jb.lda, ldb = jb.ldb, K = jb.K;
  const int tid = ltid(), wid = __builtin_amdgcn_readfirstlane(tid >> 6), lane = tid & 63, wr = wid >> 2, wc = wid & 3, fr = lane & 15, fq = lane >> 4;
  unsigned voffA[2], voffB[2];
#pragma unroll
  for (int i = 0; i < 2; ++i) { int R, C; stage_rc(tid * 16 + i * 8192, R, C); const int Rb = (R & ~31) + perm32(R & 31); voffA[i] = (unsigned)(R * lda + C) * 2u; voffB[i] = (unsigned)(Rb * ldb + C) * 2u; }
  const size_t hA = (size_t)HALF * lda * 2, hB = (size_t)HALF * ldb * 2;
  const unsigned ldsw = (unsigned)wid * 1024u;
  const int aoff = lds_byte(wr * 64 + fr, fq * 8), boff = lds_byte(wc * 32 + fr, fq * 8);
  constexpr int HTB = HT * 2;
#define SA(b,h) (((b)*2+(h))*HTB)
#define SB(b,h) ((4+(b)*2+(h))*HTB)
#define STAGE(bufoff,gbase,voff) do{ _Pragma("unroll") for(int _i=0;_i<2;++_i) \
    __builtin_amdgcn_global_load_lds((const unsigned*)((const char*)(gbase)+(voff)[_i]),(LAS unsigned*)(lds+(bufoff)+ldsw+_i*8192),16,0,0);}while(0)
#define LDA(dst,b,h) do{ _Pragma("unroll") for(int m=0;m<4;++m) _Pragma("unroll") for(int k=0;k<2;++k) dst[m][k]=*(const LAS bf16x8*)(lds+SA(b,h)+aoff+m*2048+k*1024);}while(0)
#define LDB(dst,b,h) do{ _Pragma("unroll") for(int n=0;n<2;++n) _Pragma("unroll") for(int k=0;k<2;++k) dst[n][k]=*(const LAS bf16x8*)(lds+SB(b,h)+boff+n*2048+k*1024);}while(0)
#define MMA(ai,bj,At_,Bt_) do{__builtin_amdgcn_s_setprio(1); \
    _Pragma("unroll") for(int m=0;m<4;++m) _Pragma("unroll") for(int n=0;n<2;++n) _Pragma("unroll") for(int k=0;k<2;++k) \
      acc[ai][bj][m][n]=__builtin_amdgcn_mfma_f32_16x16x32_bf16(Bt_[n][k],At_[m][k],acc[ai][bj][m][n],0,0,0); \
    __builtin_amdgcn_s_setprio(0);}while(0)
#define WAIT_V(n) asm volatile("s_waitcnt vmcnt(" #n ")":::"memory")
#define WAIT_L(n) asm volatile("s_waitcnt lgkmcnt(" #n ")":::"memory")
#define BAR __builtin_amdgcn_s_barrier()
#define SCHED __builtin_amdgcn_sched_barrier(0)
  f32x4 acc[2][2][4][2];
#pragma unroll
  for (int a = 0; a < 2; ++a)
#pragma unroll
    for (int b = 0; b < 2; ++b)
#pragma unroll
      for (int m = 0; m < 4; ++m)
#pragma unroll
        for (int n = 0; n < 2; ++n) acc[a][b][m][n] = (f32x4){0.f, 0.f, 0.f, 0.f};
  bf16x8 At[4][2], B0[2][2], B1[2][2];
  const int nt = K / BK;
  const char* cA = (const char*)jb.A + (size_t)brow * lda * 2; const char* cB = (const char*)jb.Bt + (size_t)bcol * ldb * 2;
  STAGE(SB(0,0),cB,voffB); STAGE(SA(0,0),cA,voffA);
  STAGE(SB(0,1),cB+hB,voffB); STAGE(SA(0,1),cA+hA,voffA);
  if (wr == 1) BAR;
  WAIT_V(4); BAR;
  STAGE(SB(1,0),cB+128,voffB); STAGE(SA(1,0),cA+128,voffA); STAGE(SB(1,1),cB+hB+128,voffB);
  WAIT_V(6); BAR;
  for (int t = 0; t < nt - 2; t += 2) {
    if (jb.mode == 7 && (t == 16 || t == 32)) {
      const int seg = (t >> 4) - 1;
      const bf16_t* gp = (const bf16_t*)jb.aux + (size_t)(brow + wr * 64 + fr) * NGATE + seg * 2048 + bcol + wc * 32 + fq * 8;
#pragma unroll
      for (int ai = 0; ai < 2; ++ai)
#pragma unroll
        for (int m = 0; m < 4; ++m)
#pragma unroll
          for (int bj = 0; bj < 2; ++bj)
#pragma unroll
            for (int n = 0; n < 2; ++n) {
              const bf16_t* g = gp + (size_t)(ai * HALF + m * 16) * NGATE + bj * HALF + n * 4;
              const f32x4 g0 = ld_bf4(g), g1 = ld_bf4(g + 2048);
#pragma unroll
              for (int e = 0; e < 4; ++e) acc[ai][bj][m][n][e] *= g0[e] * __builtin_amdgcn_rcpf(fmaxf(g1[e], 1e-30f));
            }
    }
    const char* a1 = cA + (size_t)(t + 1) * 128; const char* a2 = a1 + 128; const char* a3 = a2 + 128;
    const char* b2 = cB + (size_t)(t + 2) * 128; const char* b3 = b2 + 128;
    LDB(B0,0,0); SCHED; LDA(At,0,0); STAGE(SA(1,1),a1+hA,voffA);
    WAIT_L(8); BAR; WAIT_L(0); MMA(0,0,At,B0); BAR; SCHED;
    LDB(B1,0,1); STAGE(SB(0,0),b2,voffB);
    BAR; WAIT_L(0); MMA(0,1,At,B1); BAR;
    LDA(At,0,1); STAGE(SA(0,0),a2,voffA);
    BAR; WAIT_L(0); MMA(1,0,At,B0); BAR; SCHED;
    STAGE(SB(0,1),b2+hB,voffB);
    WAIT_V(6); BAR; MMA(1,1,At,B1); BAR;
    LDB(B0,1,0); SCHED; LDA(At,1,0); STAGE(SA(0,1),a2+hA,voffA);
    WAIT_L(8); BAR; WAIT_L(0); MMA(0,0,At,B0); BAR; SCHED;
    LDB(B1,1,1); STAGE(SB(1,0),b3,voffB);
    BAR; WAIT_L(0); MMA(0,1,At,B1); BAR;
    LDA(At,1,1); STAGE(SA(1,0),a3,voffA);
    BAR; WAIT_L(0); MMA(1,0,At,B0); BAR; SCHED;
    STAGE(SB(1,1),b3+hB,voffB);
    WAIT_V(6); BAR; MMA(1,1,At,B1); BAR;
  }
  { LDB(B0,0,0); LDA(At,0,0); STAGE(SA(1,1),cA+(size_t)(nt-1)*128+hA,voffA);
    BAR; WAIT_L(0); MMA(0,0,At,B0); BAR;
    LDB(B1,0,1); BAR; WAIT_L(0); MMA(0,1,At,B1); BAR;
    LDA(At,0,1); WAIT_V(4); BAR; WAIT_L(0); MMA(1,0,At,B0); MMA(1,1,At,B1); BAR; }
  { LDB(B0,1,0); LDA(At,1,0); WAIT_V(2); BAR; WAIT_L(0); MMA(0,0,At,B0); BAR;
    LDB(B1,1,1); WAIT_V(0); BAR; WAIT_L(0); MMA(0,1,At,B1); BAR;
    LDA(At,1,1); BAR; WAIT_L(0); MMA(1,0,At,B0); MMA(1,1,At,B1); BAR; }
  if (wr == 0) BAR;
#pragma unroll
  for (int ai = 0; ai < 2; ++ai)
#pragma unroll
    for (int m = 0; m < 4; ++m)
#pragma unroll
      for (int bj = 0; bj < 2; ++bj)
        gemm_epi(jb, brow + ai * HALF + wr * 64 + m * 16 + fr, bcol + bj * HALF + wc * 32 + fq * 8, acc[ai][bj][m][0], acc[ai][bj][m][1]);
  __syncthreads();
#undef SA
#undef SB
#undef STAGE
#undef LDA
#undef LDB
#undef MMA
}

DEVI void gemm_job(const GJob& jb, int& cursor, int c, int G, unsigned char* lds) {
  const int nM = T / BM, nN = jb.N / BM, ntile = nM * nN;
  if (c >= 0) {
    const int slot = ((G & 7) == 0) ? (c & 7) * (G >> 3) + (c >> 3) : c;
    int first = (slot - cursor % G + G) % G;
    for (int i = first; i < ntile; i += G) {
      const int nig = WGM * nN, gid = i / nig, fm = gid * WGM, gsz = (nM - fm) < WGM ? (nM - fm) : WGM;
      const int pm = fm + ((i % nig) % gsz), pn = (i % nig) / gsz;
      gemm_tile(jb, pm * BM, pn * BM, lds);
    }
  }
  if (!jb.keep) cursor += ntile;
}

DEVI void convT(const float* __restrict__ src, int src_ld, int k_real, int n_real, bf16_t* __restrict__ dst, int dld, int k_pad, int n_pad, int& cursor, int c, int G, unsigned char* lds) {
  float* tile = (float*)lds;
  const int tk = k_pad / 128, tn = n_pad / 128, nt = tk * tn, tid = ltid(), w = tid >> 6, lane = tid & 63;
  int first = (c - cursor % G + G) % G;
  for (int i = first; i < nt; i += G) {
    const int n0 = (i / tk) * 128, k0 = (i % tk) * 128;
    { const int n = n0 + lane * 2; const bool nok = n < n_real;
      f32x2 v[16];
#pragma unroll
      for (int r = 0; r < 16; ++r) {
        const int k = k0 + w * 16 + r;
        v[r] = (f32x2){0.f, 0.f};
        if (nok && k < k_real) v[r] = __builtin_nontemporal_load((const f32x2*)(src + (size_t)k * src_ld + n));
      }
#pragma unroll
      for (int r = 0; r < 16; ++r) *(f32x2*)(tile + (w * 16 + r) * 130 + lane * 2) = v[r]; }
    __syncthreads();
    { const int n = tid >> 2, q = tid & 3;
#pragma unroll
      for (int jj = 0; jj < 4; ++jj) {
        const int k8 = (jj * 4 + q) * 8;
        const float* tp = tile + k8 * 130 + n;
        u32x4 o; o.x = cvt_pk_bf16(tp[0], tp[130]); o.y = cvt_pk_bf16(tp[260], tp[390]); o.z = cvt_pk_bf16(tp[520], tp[650]); o.w = cvt_pk_bf16(tp[780], tp[910]);
        *(u32x4*)(dst + (size_t)(n0 + n) * dld + k0 + k8) = o;
      } }
    __syncthreads();
  }
  cursor += nt;
}

__device__ void convert_layer(const Params& P, int l, unsigned mask, int c, int G, unsigned char* lds) {
  unsigned char* ws = P.ws;
  int cur = 0;
  for (int j = 0; j < 18; ++j) {
    if (!((mask >> j) & 1u)) continue;
    const float* src = nullptr; bf16_t* dst = nullptr; int sld = 0, kr = 0, nr = 0, kp = 0, np = 0;
    const float* w_in = (const float*)P.in[7] + (size_t)l * D * NIN;
    bf16_t* wtin = (bf16_t*)(ws + WT_IN + (size_t)(l & 1) * WTIN_BYTES);
    switch (j) {
      case 0: src = w_in; sld = NIN; kr = 2048; nr = 3520; dst = wtin; kp = 2048; np = 3584; break;
      case 1: src = w_in + 3520; sld = NIN; kr = 2048; nr = 512; dst = wtin + (size_t)3584 * 2048; kp = 2048; np = 512; break;
      case 2: src = w_in + 4032; sld = NIN; kr = 2048; nr = 576; dst = wtin + (size_t)4096 * 2048; kp = 2048; np = 768; break;
      case 3: src = w_in + 4608; sld = NIN; kr = 2048; nr = 2048; dst = wtin + (size_t)4864 * 2048; kp = 2048; np = 2048; break;
      case 4: src = w_in + 6656; sld = NIN; kr = 2048; nr = 6144; dst = wtin + (size_t)6912 * 2048; kp = 2048; np = 6144; break;
      case 5: src = (const float*)P.in[24] + (size_t)l * 512 * 1536; sld = 1536; kr = 512; nr = 1536; dst = (bf16_t*)(ws + WT_UQ); kp = 512; np = 1536; break;
      case 6: src = (const float*)P.in[25] + (size_t)l * 512 * 2048; sld = 2048; kr = 512; nr = 2048; dst = (bf16_t*)(ws + WT_UKV); kp = 512; np = 2048; break;
      case 7: src = (const float*)P.in[10] + (size_t)l * 96 * 1024; sld = 1024; kr = 96; nr = 1024; dst = (bf16_t*)(ws + WT_LW); kp = 256; np = 1024; break;
      case 8: src = (const float*)P.in[12] + (size_t)l * 96 * 1024; sld = 1024; kr = 96; nr = 1024; dst = (bf16_t*)(ws + WT_LA); kp = 256; np = 1024; break;
      case 9: src = (const float*)P.in[13] + (size_t)l * 256 * 1024; sld = 1024; kr = 256; nr = 1024; dst = (bf16_t*)(ws + WT_LG); kp = 256; np = 1024; break;
      case 10: if (l > 0) { src = (const float*)P.in[20] + (size_t)(l - 1) * 1024 * 64; sld = 64; kr = 1024; nr = 64; dst = (bf16_t*)(ws + WT_V1); kp = 1024; np = 256; } break;
      case 11: if (l > 0) { src = (const float*)P.in[21] + (size_t)(l - 1) * 64 * 1024; sld = 1024; kr = 64; nr = 1024; dst = (bf16_t*)(ws + WT_V2); kp = 256; np = 1024; } break;
      case 12: src = (const float*)P.in[34] + (size_t)l * 1024 * 2048; sld = 2048; kr = 1024; nr = 2048; dst = (bf16_t*)(ws + WT_BR); kp = 1024; np = 2048; break;
      case 13: src = (const float*)P.in[35] + (size_t)l * 1024 * 2048; sld = 2048; kr = 1024; nr = 2048; dst = (bf16_t*)(ws + WT_BR) + 1024; kp = 1024; np = 2048; break;
      case 14: src = (const float*)P.in[36] + (size_t)l * 1024 * 2048; sld = 2048; kr = 1024; nr = 2048; dst = (bf16_t*)(ws + WT_BR) + 2048; kp = 1024; np = 2048; break;
      case 15: src = (const float*)P.in[37] + (size_t)l * 2048 * 2048; sld = 2048; kr = 2048; nr = 2048; dst = (bf16_t*)(ws + WT_OUT); kp = 2048; np = 2048; break;
      case 16: src = (const float*)P.in[38] + (size_t)l * 2048 * 11264; sld = 11264; kr = 2048; nr = 11264; dst = (bf16_t*)(ws + WT_UP); kp = 2048; np = 11264; break;
      default: src = (const float*)P.in[41] + (size_t)l * DFF * 2048; sld = 2048; kr = DFF; nr = 2048; dst = (bf16_t*)(ws + WT_DN); kp = DFF; np = 2048; break;
    }
    if (src) convT(src, sld, kr, nr, dst, (j >= 12 && j <= 14) ? 3072 : kp, kp, np, cur, c, G, lds);
  }
  if ((mask >> 18) & 1u) {
    const float* sgw = (const float*)P.in[32] + (size_t)l * 8 * 128 * 128;
    bf16_t* wsg = (bf16_t*)(ws + WT_SG);
    for (int i = c * 512 + ltid(); i < 8 * 128 * 128; i += G * 512) {
      int s = i & 127, t = (i >> 7) & 127;
      wsg[i] = f2bf(s <= t ? sgw[i] : 0.f);
    }
  }
}

__device__ const float ROPE_INV[32] = {1.0f, 0.749894202f, 0.562341332f, 0.421696514f, 0.316227764f, 0.237137377f, 0.177827939f, 0.133352146f, 0.100000001f, 0.0749894232f, 0.0562341325f, 0.0421696492f, 0.0316227749f, 0.0237137377f, 0.0177827943f, 0.013335214f, 0.00999999978f, 0.00749894232f, 0.00562341325f, 0.00421696482f, 0.00316227763f, 0.00237137382f, 0.00177827943f, 0.00133352145f, 0.00100000005f, 0.000749894185f, 0.000562341302f, 0.000421696517f, 0.000316227757f, 0.00023713737f, 0.00017782794f, 0.00013335215f};
__device__ void phase_init(const Params& P, unsigned char* lds) {
  const int tid = ltid();
  const float* cvec = (const float*)P.in[1];
  for (int it = lbid(); it < 192; it += gridDim.x) {
    const int l = it / 96, rem = it % 96, cc = rem % 3, kc = rem / 3;
    const int col = cc * 4096 + tid * 4;
    const float* w = (const float*)P.in[3] + (size_t)l * D * 12288 + col;
    f32x4 acc0 = {0.f, 0.f, 0.f, 0.f}, acc1 = acc0;
#pragma unroll 8
    for (int i = kc * 64; i < kc * 64 + 64; ++i) {
      float cv = cvec[i]; float s = cv * sigmoidf_(cv);
      acc0 += s * __builtin_nontemporal_load((const f32x4*)(w + (size_t)i * 12288));
      acc1 += s * __builtin_nontemporal_load((const f32x4*)(w + (size_t)i * 12288 + 2048));
    }
    if (kc == 0) { acc0 += *(const f32x4*)((const float*)P.in[4] + l * 12288 + col); acc1 += *(const f32x4*)((const float*)P.in[4] + l * 12288 + col + 2048); }
    float* mo = (float*)(P.ws + WS_MOD) + l * 12288 + col;
    atomicAdd(mo, acc0[0]); atomicAdd(mo + 1, acc0[1]); atomicAdd(mo + 2, acc0[2]); atomicAdd(mo + 3, acc0[3]);
    atomicAdd(mo + 2048, acc1[0]); atomicAdd(mo + 2049, acc1[1]); atomicAdd(mo + 2050, acc1[2]); atomicAdd(mo + 2051, acc1[3]);
  }
  const int* pos = (const int*)P.in[2];
  float* cosb = (float*)(P.ws + WS_COS); float* sinb = (float*)(P.ws + WS_SIN);
  for (int i = lbid() * 512 + tid; i < T * 32; i += gridDim.x * 512) {
    int t = i >> 5, j = i & 31;
    float inv = ROPE_INV[j];
    float ang = (float)pos[t] * inv;
    double rev = (double)ang * 0.15915494309189535;
    rev -= rint(rev);
    cosb[i] = __builtin_amdgcn_cosf((float)rev);
    sinb[i] = __builtin_amdgcn_sinf((float)rev);
  }
  __syncthreads();
}

__device__ void phase_h(const float* __restrict__ x, const float* __restrict__ g, const float* __restrict__ sh, const float* __restrict__ sc, bf16_t* __restrict__ H) {
  const int wave = ltid() >> 6, lane = ltid() & 63;
  for (int row = lbid() * 8 + wave; row < T; row += gridDim.x * 8) {
    const float* xr = x + (size_t)row * D;
    f32x4 v[8]; float ss = 0.f;
#pragma unroll
    for (int i = 0; i < 8; ++i) { v[i] = __builtin_nontemporal_load((const f32x4*)(xr + i * 256 + lane * 4));   ss += v[i][0] * v[i][0] + v[i][1] * v[i][1] + v[i][2] * v[i][2] + v[i][3] * v[i][3]; }
    ss = wave_sum(ss);
    const float rstd = rsqrtf(ss * (1.f / D) + 1e-6f);
#pragma unroll
    for (int i = 0; i < 8; ++i) {
      const int c = i * 256 + lane * 4;
      f32x4 gg = *(const f32x4*)(g + c), s1 = *(const f32x4*)(sc + c), s0 = *(const f32x4*)(sh + c);
      f32x4 o = v[i] * rstd * gg * (1.f + s1) + s0;
      st_bf4(H + (size_t)row * D + c, o);
    }
  }
}

__device__ void phase_prep1(const Params& P, int l) {
  unsigned char* ws = P.ws;
  const bf16_t* Pb = (const bf16_t*)(ws + A_P);
  const float* mu = (const float*)P.in[8] + l * 3520;
  bf16_t* AL = (bf16_t*)(ws + A_AL); bf16_t* VB = (bf16_t*)(ws + A_VB);
  bf16_t* QL = (bf16_t*)(ws + A_QL); bf16_t* CKV = (bf16_t*)(ws + A_CKV); bf16_t* KR = (bf16_t*)(ws + A_KR);
  bf16_t* U = (bf16_t*)(ws + A_U); bf16_t* VN = (bf16_t*)(ws + A_VN);
  const float* cosb = (const float*)(ws + WS_COS); const float* sinb = (const float*)(ws + WS_SIN);
  const float* qn = (const float*)P.in[22] + l * 512; const float* kvn = (const float*)P.in[23] + l * 512;
  const float* knr = (const float*)P.in[29] + l * 64;
  const float* lnw = (const float*)P.in[30] + l * 1024; const float* lnb = (const float*)P.in[31] + l * 1024;
  const int wave = ltid() >> 6, lane = ltid() & 63;
  for (int t = lbid() * 8 + wave; t < T; t += gridDim.x * 8) {
    const bf16_t* pc = Pb + (size_t)t * PW; const bf16_t* pp = pc - PW; const bool hp = t > 0;
#pragma unroll
    for (int gq = 0; gq < 3; ++gq) {
      const int idx = (gq * 64 + lane) * 4, seg = idx >> 8, j = idx & 255;
      f32x4 val = {0.f, 0.f, 0.f, 0.f};
      if (seg == 2 || j < 96) {
        const int col = seg == 0 ? 3072 + j : (seg == 1 ? 3168 + j : 3264 + j);
        const f32x4 cur = ld_bf4(pc + col), prev = hp ? ld_bf4(pp + col) : (f32x4){0.f, 0.f, 0.f, 0.f};
        const f32x4 p = cur + (prev - cur) * *(const f32x4*)(mu + col);
#pragma unroll
        for (int e = 0; e < 4; ++e) val[e] = seg == 0 ? tanhf_(p[e]) : (seg == 1 ? p[e] : sigmoidf_(p[e]));
      }
      st_bf4(AL + (size_t)t * 768 + idx, val);
    }
    if (l > 0) {
#pragma unroll
      for (int i = 0; i < 4; ++i) {
        const int c = i * 256 + lane * 4, col = 2048 + c;
        f32x4 cur = ld_bf4(pc + col), prev = hp ? ld_bf4(pp + col) : (f32x4){0.f, 0.f, 0.f, 0.f};
        f32x4 m = *(const f32x4*)(mu + col);
        st_bf4(VB + (size_t)t * 1024 + c, cur + (prev - cur) * m);
      }
    }
#pragma unroll
    for (int which = 0; which < 2; ++which) {
      const int col = (which == 0 ? PC_DQ : PC_CKV) + lane * 8;
      f32x4 a = ld_bf4(pc + col), b = ld_bf4(pc + col + 4);
      float ss = a[0] * a[0] + a[1] * a[1] + a[2] * a[2] + a[3] * a[3] + b[0] * b[0] + b[1] * b[1] + b[2] * b[2] + b[3] * b[3];
      ss = wave_sum(ss);
      const float rstd = rsqrtf(ss * (1.f / 512.f) + 1e-6f);
      const float* gn = (which == 0 ? qn : kvn) + lane * 8;
      bf16_t* dst = (which == 0 ? QL : CKV) + (size_t)t * 512 + lane * 8;
      st_bf4(dst, a * rstd * *(const f32x4*)gn); st_bf4(dst + 4, b * rstd * *(const f32x4*)(gn + 4));
    }
    {
      float xv = bf2f(pc[PC_KR + lane]);
      float ss = wave_sum(xv * xv);
      float y = xv * rsqrtf(ss * (1.f / 64.f) + 1e-6f) * knr[lane];
      float oth = __shfl_xor(y, 32);
      const int j = lane & 31; float cs = cosb[t * 32 + j], sn = sinb[t * 32 + j];
      float o = lane < 32 ? (y * cs - oth * sn) : (oth * sn + y * cs);
      KR[(size_t)t * 64 + lane] = f2bf(o);
    }
    {
      f32x4 uu[4], vv[4]; float s1 = 0.f;
#pragma unroll
      for (int i = 0; i < 4; ++i) {
        const int c = i * 256 + lane * 4;
        uu[i] = ld_bf4(pc + PC_U + c); vv[i] = ld_bf4(pc + PC_VS + c);
#pragma unroll
        for (int e = 0; e < 4; ++e) { uu[i][e] = geluf_(uu[i][e]); vv[i][e] = geluf_(vv[i][e]); s1 += vv[i][e]; }
      }
      s1 = wave_sum(s1); const float mean = s1 * (1.f / 1024.f); float s2 = 0.f;
#pragma unroll
      for (int i = 0; i < 4; ++i)
#pragma unroll
        for (int e = 0; e < 4; ++e) { float d = vv[i][e] - mean; s2 += d * d; }
      s2 = wave_sum(s2); const float rstd = rsqrtf(s2 * (1.f / 1024.f) + 1e-5f);
#pragma unroll
      for (int i = 0; i < 4; ++i) {
        const int c = i * 256 + lane * 4;
        st_bf4(U + (size_t)t * 1024 + c, uu[i]);
        st_bf4(VN + (size_t)t * 1024 + c, (vv[i] - mean) * rstd * *(const f32x4*)(lnw + c) + *(const f32x4*)(lnb + c));
      }
    }
  }
}

__device__ void phase_prep2(const Params& P, int l, unsigned char* lds) {
  unsigned char* ws = P.ws;
  const bf16_t* Pb = (const bf16_t*)(ws + A_P);
  const float* mu = (const float*)P.in[8] + l * 3520;
  const float* w0 = (const float*)P.in[9] + l * 1024; const float* a0 = (const float*)P.in[11] + l * 1024;
  const float* k_k = (const float*)P.in[14] + l * 1024; const float* k_a = (const float*)P.in[15] + l * 1024;
  const float* v0 = (const float*)P.in[19];
  float* LW = (float*)(ws + A_LW); float* LA = (float*)(ws + A_LA); float* VG = (float*)(ws + A_VG); float* VF = (float*)(ws + WS_VF);
  float* KK = (float*)(ws + A_KK); bf16_t* KH = (bf16_t*)(ws + A_KH); bf16_t* R = (bf16_t*)(ws + A_R);
  const int wave = ltid() >> 6, lane = ltid() & 63, tid = ltid();
  const f32x4 z4 = {0.f, 0.f, 0.f, 0.f};
  for (int t = lbid() * 8 + wave; t < T; t += gridDim.x * 8) {
    const bf16_t* pc = Pb + (size_t)t * PW; const bf16_t* pp = pc - PW; const bool hp = t > 0;
#pragma unroll
    for (int i = 0; i < 4; ++i) {
      const int c = i * 256 + lane * 4; const size_t o = (size_t)t * 1024 + c;
      f32x4 rc = ld_bf4(pc + c), kc = ld_bf4(pc + 1024 + c), vc = ld_bf4(pc + 2048 + c);
      f32x4 rp = hp ? ld_bf4(pp + c) : z4, kp = hp ? ld_bf4(pp + 1024 + c) : z4, vp = hp ? ld_bf4(pp + 2048 + c) : z4;
      f32x4 r = rc + (rp - rc) * *(const f32x4*)(mu + c);
      f32x4 k = kc + (kp - kc) * *(const f32x4*)(mu + 1024 + c);
      f32x4 v = vc + (vp - vc) * *(const f32x4*)(mu + 2048 + c);
      if (l > 0) {
        f32x4 vg = *(const f32x4*)(VG + o), vf = *(const f32x4*)(VF + o), vz = *(const f32x4*)(v0 + c);
#pragma unroll
        for (int e = 0; e < 4; ++e) v[e] = v[e] + (vf[e] - v[e]) * sigmoidf_(vz[e] + vg[e]);
      } else { *(f32x4*)(VF + o) = v; }
      f32x4 lw = *(const f32x4*)(LW + o), la = *(const f32x4*)(LA + o);
      f32x4 w0v = *(const f32x4*)(w0 + c), a0v = *(const f32x4*)(a0 + c), kkv = *(const f32x4*)(k_k + c), kav = *(const f32x4*)(k_a + c);
      f32x4 dec, al, kk, kh; float ss = 0.f;
#pragma unroll
      for (int e = 0; e < 4; ++e) {
        float z = w0v[e] + lw[e];
        float sp = fmaxf(-z, 0.f) + __logf(1.f + __expf(-fabsf(z)));
        float wl = -sp - 0.5f;
        dec[e] = __expf(-__expf(wl));
        al[e] = sigmoidf_(a0v[e] + la[e]);
        kk[e] = k[e] * kkv[e]; ss += kk[e] * kk[e];
        kh[e] = k[e] * (1.f + (al[e] - 1.f) * kav[e]);
      }
      ss = sum16(ss);
      const float inv = 1.f / fmaxf(sqrtf(ss), 1e-12f);
      kk = kk * inv;
      *(f32x4*)(LW + o) = dec; *(f32x4*)(LA + o) = -(kk * al); *(f32x4*)(VG + o) = v; *(f32x4*)(KK + o) = kk;
      st_bf4(KH + o, kh); st_bf4(R + o, r);
    }
  }
  const bf16_t* QRAW = (const bf16_t*)(ws + A_QRAW); const bf16_t* KVRAW = (const bf16_t*)(ws + A_KVRAW); const bf16_t* KR = (const bf16_t*)(ws + A_KR);
  bf16_t* Q = (bf16_t*)(ws + A_Q); bf16_t* Kd = (bf16_t*)(ws + A_K); bf16_t* VT = (bf16_t*)(ws + A_VT);
  const float* cosb = (const float*)(ws + WS_COS); const float* sinb = (const float*)(ws + WS_SIN);
  const float* qnn = (const float*)P.in[26] + l * 128; const float* qnr = (const float*)P.in[27] + l * 64; const float* knn = (const float*)P.in[28] + l * 128;
  const float QS = 0.07216878364870322f * 1.4426950408889634f;
  for (int t = lbid() * 8 + wave; t < T; t += gridDim.x * 8) {
    const int j = lane & 31; const float cs = cosb[t * 32 + j], sn = sinb[t * 32 + j];
    const unsigned krv = KR[(size_t)t * 64 + lane];
    for (int h = 0; h < 8; ++h) {
      const bf16_t* qr = QRAW + (size_t)t * 1536 + h * 192;
      unsigned u = __builtin_nontemporal_load((const unsigned*)(qr + lane * 2));
      float a = bf_lo(u), b = bf_hi(u);
      float ss = wave_sum(a * a + b * b); float rstd = rsqrtf(ss * (1.f / 128.f) + 1e-6f);
      bf16_t* qo = Q + ((size_t)h * T + t) * 192;
      *(unsigned*)(qo + lane * 2) = cvt_pk_bf16(a * rstd * qnn[lane * 2] * QS, b * rstd * qnn[lane * 2 + 1] * QS);
      float xr = bf2f(qr[128 + lane]);
      float s2 = wave_sum(xr * xr); float y = xr * rsqrtf(s2 * (1.f / 64.f) + 1e-6f) * qnr[lane];
      float oth = __shfl_xor(y, 32);
      float o = lane < 32 ? (y * cs - oth * sn) : (oth * sn + y * cs);
      qo[128 + lane] = f2bf(o * QS);
      const bf16_t* kr = KVRAW + (size_t)t * 2048 + h * 256;
      unsigned uk = __builtin_nontemporal_load((const unsigned*)(kr + lane * 2));
      float ka = bf_lo(uk), kb = bf_hi(uk);
      float sk = wave_sum(ka * ka + kb * kb); float rk = rsqrtf(sk * (1.f / 128.f) + 1e-6f);
      bf16_t* ko = Kd + ((size_t)h * T + t) * 192;
      *(unsigned*)(ko + lane * 2) = cvt_pk_bf16(ka * rk * knn[lane * 2], kb * rk * knn[lane * 2 + 1]);
      ko[128 + lane] = (bf16_t)krv;
    }
  }
  bf16_t* tl = (bf16_t*)lds;
  for (int it = lbid(); it < 8 * (T / 64); it += gridDim.x) {
    const int h = it & 7, tb = it >> 3;
    __syncthreads();
    { const int tt = tid >> 3, dc = (tid & 7) * 16;
      const bf16_t* src = KVRAW + (size_t)(tb * 64 + tt) * 2048 + h * 256 + 128 + dc;
      *(u32x4*)(tl + tt * 136 + dc) = *(const u32x4*)src; *(u32x4*)(tl + tt * 136 + dc + 8) = *(const u32x4*)(src + 8); }
    __syncthreads();
    { const int dv = tid >> 2, tq = (tid & 3) * 16;
      unsigned o[8];
#pragma unroll
      for (int i = 0; i < 8; ++i) o[i] = (unsigned)tl[(tq + 2 * i) * 136 + dv] | ((unsigned)tl[(tq + 2 * i + 1) * 136 + dv] << 16);
      bf16_t* dst = VT + (((size_t)h * (T / 64) + tb) * 128 + dv) * 64 + tq;
      *(u32x4*)dst = (u32x4){o[0], o[1], o[2], o[3]}; *(u32x4*)(dst + 8) = (u32x4){o[4], o[5], o[6], o[7]}; }
  }
}

constexpr int SC_CH = 32, SC_STEP = 336, SC_STAGE = SC_CH * SC_STEP;
__device__ void scan_block(const Params& P, int sb, unsigned char* lds) {
  unsigned char* ws = P.ws;
  const float* LW = (const float*)(ws + A_LW); const float* LA = (const float*)(ws + A_LA); const float* VG = (const float*)(ws + A_VG);
  const float* KK = (const float*)(ws + A_KK); const bf16_t* KH = (const bf16_t*)(ws + A_KH); const bf16_t* R = (const bf16_t*)(ws + A_R);
  float* Y = (float*)(ws + A_YSC);
  float* buf = (float*)lds;
  const int head = sb >> 2, rg = sb & 3, tid = ltid();
  const bool loader = tid >= 256; const int lt = tid - 256;
  const int lane = tid & 63, wv = (tid >> 6) & 3, ks = lane & 15, myrow = wv * 4 + (lane >> 4);
  f32x4 S = {0.f, 0.f, 0.f, 0.f};
  const int hb = head * 64;
  struct Batch { f32x4 g0[2], g1[2], g2[2], gv; u32x4 h0, h1; };
  auto ld_chunk = [&](Batch& B, int c) {
    const int t0 = c * SC_CH;
#pragma unroll
    for (int i = 0; i < 2; ++i) { const int idx = lt + i * 256, st = idx >> 4, c4 = (idx & 15) * 4; const size_t o = (size_t)(t0 + st) * 1024 + hb + c4;
      B.g0[i] = *(const f32x4*)(LW + o); B.g1[i] = *(const f32x4*)(KK + o); B.g2[i] = *(const f32x4*)(LA + o); }
    { const int st = lt >> 3, c8 = (lt & 7) * 8; const size_t o = (size_t)(t0 + st) * 1024 + hb + c8; B.h0 = *(const u32x4*)(KH + o); B.h1 = *(const u32x4*)(R + o); }
    if (lt < 128) { const int st = lt >> 2, r4 = (lt & 3) * 4; B.gv = *(const f32x4*)(VG + (size_t)(t0 + st) * 1024 + hb + rg * 16 + r4); }
  };
  auto st_chunk = [&](const Batch& B, int s) {
    float* b = buf + s * SC_STAGE;
#pragma unroll
    for (int i = 0; i < 2; ++i) { const int idx = lt + i * 256, st = idx >> 4, c4 = (idx & 15) * 4; float* d = b + st * SC_STEP + c4;
      *(f32x4*)(d) = B.g0[i]; *(f32x4*)(d + 64) = B.g1[i]; *(f32x4*)(d + 128) = B.g2[i]; }
    { const int st = lt >> 3, c8 = (lt & 7) * 8; float* d = b + st * SC_STEP + c8;
      *(f32x4*)(d + 192) = (f32x4){bf_lo(B.h0.x), bf_hi(B.h0.x), bf_lo(B.h0.y), bf_hi(B.h0.y)}; *(f32x4*)(d + 196) = (f32x4){bf_lo(B.h0.z), bf_hi(B.h0.z), bf_lo(B.h0.w), bf_hi(B.h0.w)};
      *(f32x4*)(d + 256) = (f32x4){bf_lo(B.h1.x), bf_hi(B.h1.x), bf_lo(B.h1.y), bf_hi(B.h1.y)}; *(f32x4*)(d + 260) = (f32x4){bf_lo(B.h1.z), bf_hi(B.h1.z), bf_lo(B.h1.w), bf_hi(B.h1.w)}; }
    if (lt < 128) { const int st = lt >> 2, r4 = (lt & 3) * 4; *(f32x4*)(b + st * SC_STEP + 320 + r4) = B.gv; }
  };
  const int NCH = T / SC_CH;
  __syncthreads();
  if (loader) {
    Batch b0, b1, b2, b3;
    ld_chunk(b0, 0); st_chunk(b0, 0); ld_chunk(b1, 1); ld_chunk(b2, 2); ld_chunk(b3, 3); ld_chunk(b0, 4);
    __syncthreads();
    for (int c = 0; c < NCH; c += 4) {
      if (c + 1 < NCH) st_chunk(b1, (c + 1) & 1);
      if (c + 5 < NCH) ld_chunk(b1, c + 5);
      __syncthreads();
      if (c + 2 < NCH) st_chunk(b2, (c + 2) & 1);
      if (c + 6 < NCH) ld_chunk(b2, c + 6);
      __syncthreads();
      if (c + 3 < NCH) st_chunk(b3, (c + 3) & 1);
      if (c + 7 < NCH) ld_chunk(b3, c + 7);
      __syncthreads();
      if (c + 4 < NCH) st_chunk(b0, (c + 4) & 1);
      if (c + 8 < NCH) ld_chunk(b0, c + 8);
      __syncthreads();
    }
  } else {
    __builtin_amdgcn_s_setprio(2);
    __syncthreads();
    for (int c = 0; c < NCH; ++c) {
      const float* b = buf + (c & 1) * SC_STAGE;
      const float* q = b + ks * 4;
      const float* qv = b + 320 + myrow;
      float* yo = Y + (size_t)(c * SC_CH + ks) * 1024 + hb + rg * 16 + myrow;
      f32x4 w4 = *(const f32x4*)(q), k4 = *(const f32x4*)(q + 64), b4 = *(const f32x4*)(q + 128), kh4 = *(const f32x4*)(q + 192), r4 = *(const f32x4*)(q + 256);
      float v = qv[0];
      float yk = 0.f, ypart = 0.f;
#pragma unroll
      for (int s = 0; s < SC_CH; ++s) {
        f32x4 w4n, k4n, b4n, kh4n, r4n; float vn;
        if (s + 1 < SC_CH) {
          const float* qn = q + (s + 1) * SC_STEP;
          w4n = *(const f32x4*)(qn); k4n = *(const f32x4*)(qn + 64); b4n = *(const f32x4*)(qn + 128); kh4n = *(const f32x4*)(qn + 192); r4n = *(const f32x4*)(qn + 256);
          vn = qv[(s + 1) * SC_STEP];
        }
        __builtin_amdgcn_sched_barrier(0);
        if (s > 0) {
          const float y = dpp_allreduce16(ypart);
          yk = (ks == ((s - 1) & 15)) ? y : yk;
          if (((s - 1) & 15) == 15) yo[(size_t)(s - 16) * 1024] = yk;
        }
        const f32x2 pp = (f32x2){S[0], S[1]} * (f32x2){k4[0], k4[1]} + (f32x2){S[2], S[3]} * (f32x2){k4[2], k4[3]};
        const f32x4 A = S * w4 + v * kh4;
        const float ar = dpp_allreduce16(pp.x + pp.y);
        S = A + ar * b4;
        const f32x2 yy = (f32x2){S[0], S[1]} * (f32x2){r4[0], r4[1]} + (f32x2){S[2], S[3]} * (f32x2){r4[2], r4[3]};
        ypart = yy.x + yy.y;
        if (s + 1 < SC_CH) { w4 = w4n; k4 = k4n; b4 = b4n; kh4 = kh4n; r4 = r4n; v = vn; }
      }
      { const float y = dpp_allreduce16(ypart); yk = (ks == 15) ? y : yk; yo[(size_t)16 * 1024] = yk; }
      __syncthreads();
    }
    __builtin_amdgcn_s_setprio(0);
  }
}

constexpr int AT_KROW = 400, AT_VROW = 144, AT_K = 64 * AT_KROW, AT_STAGE = AT_K + 128 * AT_VROW;
__device__ void attn_block(const Params& P, int h, int qb, unsigned char* lds) {
  unsigned char* ws = P.ws;
  const bf16_t* Q = (const bf16_t*)(ws + A_Q); const bf16_t* Kd = (const bf16_t*)(ws + A_K); const bf16_t* VT = (const bf16_t*)(ws + A_VT);
  bf16_t* Y3 = (bf16_t*)(ws + A_Y3);
  const int tid = ltid(), w = tid >> 6, lane = tid & 63, fr = lane & 15, fq = lane >> 4;
  const int q0 = qb * 256, wq0 = q0 + w * 32;
  bf16x8 qf[2][6];
#pragma unroll
  for (int r2 = 0; r2 < 2; ++r2) {
    const bf16_t* qg = Q + ((size_t)h * T + wq0 + r2 * 16 + fr) * 192 + fq * 8;
#pragma unroll
    for (int kk = 0; kk < 6; ++kk) qf[r2][kk] = *(const bf16x8*)(qg + kk * 32);
  }
  f32x4 o[2][8];
#pragma unroll
  for (int r2 = 0; r2 < 2; ++r2)
#pragma unroll
    for (int n = 0; n < 8; ++n) o[r2][n] = (f32x4){0.f, 0.f, 0.f, 0.f};
  float m[2] = {-1e30f, -1e30f}, l[2] = {0.f, 0.f};
  const int ntiles = (q0 + 256) / 64;
  const bf16_t* Kh = Kd + (size_t)h * T * 192; const bf16_t* Vh = VT + (size_t)h * 128 * T;
  u32x4 kr[3], vr[2];
  auto ld_tile = [&](int kt) {
    const int k0 = kt * 64;
#pragma unroll
    for (int i = 0; i < 3; ++i) { const int c = tid + i * 512, row = c / 24, cc = c % 24; kr[i] = *(const u32x4*)(Kh + (size_t)(k0 + row) * 192 + cc * 8); }
#pragma unroll
    for (int i = 0; i < 2; ++i) { const int c = tid + i * 512; vr[i] = *(const u32x4*)(Vh + (size_t)kt * 8192 + c * 8); }
  };
  auto st_tile = [&](int s) {
    unsigned char* b = lds + s * AT_STAGE;
#pragma unroll
    for (int i = 0; i < 3; ++i) { const int c = tid + i * 512, row = c / 24, cc = c % 24; *(u32x4*)(b + row * AT_KROW + cc * 16) = kr[i]; }
#pragma unroll
    for (int i = 0; i < 2; ++i) { const int c = tid + i * 512, dv = c >> 3, cc = c & 7, x = dv & 31, row = (dv & ~31) + ((x >> 2) & 1) * 16 + (x >> 3) * 4 + (x & 3);
      *(u32x4*)(b + AT_K + row * AT_VROW + cc * 16) = vr[i]; }
  };
  __syncthreads();
  ld_tile(0); st_tile(0);
  __syncthreads();
  for (int kt = 0; kt < ntiles; ++kt) {
    const int k0 = kt * 64;
    if (kt + 1 < ntiles) ld_tile(kt + 1);
    if (k0 <= wq0 + 31) {
      const unsigned char* kb = lds + (kt & 1) * AT_STAGE; const unsigned char* vb = kb + AT_K;
      f32x4 s[2][4];
#pragma unroll
      for (int sub = 0; sub < 4; ++sub) {
        s[0][sub] = (f32x4){0.f, 0.f, 0.f, 0.f}; s[1][sub] = s[0][sub];
#pragma unroll
        for (int kk = 0; kk < 6; ++kk) {
          bf16x8 a = *(const bf16x8*)(kb + (sub * 16 + fr) * AT_KROW + (kk * 32 + fq * 8) * 2);
          s[0][sub] = __builtin_amdgcn_mfma_f32_16x16x32_bf16(a, qf[0][kk], s[0][sub], 0, 0, 0);
          s[1][sub] = __builtin_amdgcn_mfma_f32_16x16x32_bf16(a, qf[1][kk], s[1][sub], 0, 0, 0);
        }
      }
      u32x4 pk[2][2];
#pragma unroll
      for (int r2 = 0; r2 < 2; ++r2) {
        const int qrow = wq0 + r2 * 16 + fr;
        if (k0 + 63 > wq0 + r2 * 16) {
#pragma unroll
          for (int sub = 0; sub < 4; ++sub)
#pragma unroll
            for (int j = 0; j < 4; ++j) if (k0 + sub * 16 + fq * 4 + j > qrow) s[r2][sub][j] = -1e30f;
        }
        float mx = -1e30f;
#pragma unroll
        for (int sub = 0; sub < 4; ++sub)
#pragma unroll
          for (int j = 0; j < 4; ++j) mx = fmaxf(mx, s[r2][sub][j]);
        mx = xrow_max(mx);
        float mn = m[r2];
        if (__builtin_amdgcn_ballot_w64(mx - mn > 8.f) != 0ull) {
          mn = fmaxf(m[r2], mx);
          const float alpha = __builtin_amdgcn_exp2f(m[r2] - mn);
          m[r2] = mn; l[r2] *= alpha;
#pragma unroll
          for (int n = 0; n < 8; ++n) o[r2][n] *= alpha;
        }
        float ps = 0.f;
#pragma unroll
        for (int sub = 0; sub < 4; ++sub)
#pragma unroll
          for (int j = 0; j < 4; ++j) { s[r2][sub][j] = __builtin_amdgcn_exp2f(s[r2][sub][j] - mn); ps += s[r2][sub][j]; }
        l[r2] += ps;
#pragma unroll
        for (int kg = 0; kg < 2; ++kg) {
          pk[r2][kg].x = cvt_pk_bf16(s[r2][2 * kg][0], s[r2][2 * kg][1]); pk[r2][kg].y = cvt_pk_bf16(s[r2][2 * kg][2], s[r2][2 * kg][3]);
          pk[r2][kg].z = cvt_pk_bf16(s[r2][2 * kg + 1][0], s[r2][2 * kg + 1][1]); pk[r2][kg].w = cvt_pk_bf16(s[r2][2 * kg + 1][2], s[r2][2 * kg + 1][3]);
        }
      }
#pragma unroll
      for (int kg = 0; kg < 2; ++kg) {
        const bf16x8 pb0 = __builtin_bit_cast(bf16x8, pk[0][kg]), pb1 = __builtin_bit_cast(bf16x8, pk[1][kg]);
#pragma unroll
        for (int n = 0; n < 8; ++n) {
          const unsigned char* vp = vb + (n * 16 + fr) * AT_VROW + (kg * 32 + fq * 4) * 2;
          u32x2 v0 = *(const u32x2*)vp, v1 = *(const u32x2*)(vp + 32);
          const bf16x8 va = __builtin_bit_cast(bf16x8, ((u32x4){v0.x, v0.y, v1.x, v1.y}));
          o[0][n] = __builtin_amdgcn_mfma_f32_16x16x32_bf16(va, pb0, o[0][n], 0, 0, 0);
          o[1][n] = __builtin_amdgcn_mfma_f32_16x16x32_bf16(va, pb1, o[1][n], 0, 0, 0);
        }
      }
    }
    if (kt + 1 < ntiles) st_tile((kt + 1) & 1);
    __syncthreads();
  }
#pragma unroll
  for (int r2 = 0; r2 < 2; ++r2) {
    float lt = xrow_sum(l[r2]);
    const float inv = 1.f / lt;
    bf16_t* yo = Y3 + (size_t)(wq0 + r2 * 16 + fr) * 3072 + 1024 + h * 128 + fq * 8;
#pragma unroll
    for (int n = 0; n < 8; n += 2) *(u32x4*)(yo + (n >> 1) * 32) = pack8(o[r2][n] * inv, o[r2][n + 1] * inv);
  }
}

__device__ void sg_item(const Params& P, int l, int n, int g, unsigned char* lds) {
  unsigned char* ws = P.ws;
  const bf16_t* VN = (const bf16_t*)(ws + A_VN); const bf16_t* U = (const bf16_t*)(ws + A_U); const bf16_t* WS = (const bf16_t*)(ws + WT_SG);
  bf16_t* Y3 = (bf16_t*)(ws + A_Y3);
  const float* sb = (const float*)P.in[33] + (size_t)l * 1024 + g * 128;
  bf16_t* vt = (bf16_t*)lds;
  const int tid = ltid(), w = tid >> 6, lane = tid & 63, fr = lane & 15, fq = lane >> 4;
  __syncthreads();
#pragma unroll
  for (int i = 0; i < 4; ++i) {
    const int c = tid + i * 512, s = c >> 4, c8 = (c & 15) * 8;
    u32x4 v = *(const u32x4*)(VN + (size_t)(n * 128 + s) * 1024 + g * 128 + c8);
    const unsigned vv[4] = {v.x, v.y, v.z, v.w};
#pragma unroll
    for (int e = 0; e < 4; ++e) { vt[(c8 + 2 * e) * 136 + s] = (bf16_t)(vv[e] & 0xffff); vt[(c8 + 2 * e + 1) * 136 + s] = (bf16_t)(vv[e] >> 16); }
  }
  __syncthreads();
  const int trow = w * 16 + fr;
  bf16x8 wf[4];
  const bf16_t* wp = WS + ((size_t)g * 128 + trow) * 128 + fq * 8;
#pragma unroll
  for (int kk = 0; kk < 4; ++kk) wf[kk] = *(const bf16x8*)(wp + kk * 32);
  const int tt = n * 128 + trow;
  const float bias = sb[trow];
#pragma unroll
  for (int nn = 0; nn < 8; ++nn) {
    f32x4 acc = {0.f, 0.f, 0.f, 0.f};
#pragma unroll
    for (int kk = 0; kk < 4; ++kk) {
      bf16x8 b = *(const bf16x8*)(vt + (nn * 16 + fr) * 136 + kk * 32 + fq * 8);
      acc = __builtin_amdgcn_mfma_f32_16x16x32_bf16(b, wf[kk], acc, 0, 0, 0);
    }
    const int cc = g * 128 + nn * 16 + fq * 4;
    f32x4 u = ld_bf4(U + (size_t)tt * 1024 + cc);
    st_bf4(Y3 + (size_t)tt * 3072 + 2048 + cc, u * (acc + bias));
  }
}

__device__ void phase_post(const Params& P, int l) {
  unsigned char* ws = P.ws;
  const float* Y = (const float*)(ws + A_YSC); const float* VG = (const float*)(ws + A_VG);
  const bf16_t* KH = (const bf16_t*)(ws + A_KH); const bf16_t* R = (const bf16_t*)(ws + A_R); const bf16_t* LG = (const bf16_t*)(ws + A_LG);
  bf16_t* Y3 = (bf16_t*)(ws + A_Y3);
  const float* rk = (const float*)P.in[16] + l * 1024; const float* lw = (const float*)P.in[17] + l * 1024; const float* lb = (const float*)P.in[18] + l * 1024;
  const int wave = ltid() >> 6, lane = ltid() & 63;
  for (int t = lbid() * 8 + wave; t < T; t += gridDim.x * 8) {
#pragma unroll
    for (int i = 0; i < 4; ++i) {
      const int c = i * 256 + lane * 4; const size_t o = (size_t)t * 1024 + c;
      auto ntb = [](const bf16_t* p) { const u32x2 u = __builtin_nontemporal_load((const u32x2*)p); return (f32x4){bf_lo(u.x), bf_hi(u.x), bf_lo(u.y), bf_hi(u.y)}; };
      f32x4 y = __builtin_nontemporal_load((const f32x4*)(Y + o)), v = __builtin_nontemporal_load((const f32x4*)(VG + o)), r = ntb(R + o), kh = ntb(KH + o), g = ntb(LG + o);
      f32x4 rkv = *(const f32x4*)(rk + c);
      float s1 = sum16(y[0] + y[1] + y[2] + y[3]); const float mean = s1 * (1.f / 64.f);
      f32x4 d = y - mean;
      float s2 = sum16(d[0] * d[0] + d[1] * d[1] + d[2] * d[2] + d[3] * d[3]); const float rstd = rsqrtf(s2 * (1.f / 64.f) + 64e-5f);
      float bs = sum16(r[0] * kh[0] * rkv[0] + r[1] * kh[1] * rkv[1] + r[2] * kh[2] * rkv[2] + r[3] * kh[3] * rkv[3]);
      f32x4 out = (d * rstd * *(const f32x4*)(lw + c) + *(const f32x4*)(lb + c) + bs * v) * g;
      st_bf4(Y3 + (size_t)t * 3072 + c, out);
    }
  }
}

__device__ void phase_conv(const Params& P, int l) {
  unsigned char* ws = P.ws;
  const bf16_t* UP = (const bf16_t*)(ws + A_UP); bf16_t* ACT = (bf16_t*)(ws + A_ACT);
  const float* cw = (const float*)P.in[39] + (size_t)l * 3 * 11264; const float* cb = (const float*)P.in[40] + (size_t)l * 11264;
  const int tid = ltid(), wave = tid >> 6, lane = tid & 63;
  constexpr int RC = 32, NCG = DFF / 256;
  const f32x4 z4 = {0.f, 0.f, 0.f, 0.f};
  for (int item = lbid() * 8 + wave; item < (T / RC) * NCG; item += gridDim.x * 8) {
    const int cg = item % NCG, t0 = (item / NCG) * RC;
    const int j = (cg * 64 + lane) * 4;
    const f32x4 wg0 = *(const f32x4*)(cw + j), wg1 = *(const f32x4*)(cw + 11264 + j), wg2 = *(const f32x4*)(cw + 2 * 11264 + j), bg = *(const f32x4*)(cb + j);
    const f32x4 wv0 = *(const f32x4*)(cw + DFF + j), wv1 = *(const f32x4*)(cw + 11264 + DFF + j), wv2 = *(const f32x4*)(cw + 2 * 11264 + DFF + j), bv = *(const f32x4*)(cb + DFF + j);
    const bf16_t* up = UP + (size_t)t0 * 11264 + j;
    f32x4 g1 = t0 >= 1 ? ld_bf4(up - 11264) : z4, g2 = t0 >= 2 ? ld_bf4(up - 2 * 11264) : z4;
    f32x4 v1 = t0 >= 1 ? ld_bf4(up - 11264 + DFF) : z4, v2 = t0 >= 2 ? ld_bf4(up - 2 * 11264 + DFF) : z4;
    bf16_t* ao = ACT + (size_t)t0 * DFF + j;
#pragma unroll 8
    for (int t = 0; t < RC; ++t) {
      const u32x2 gr = __builtin_nontemporal_load((const u32x2*)(up + (size_t)t * 11264)), vr = __builtin_nontemporal_load((const u32x2*)(up + (size_t)t * 11264 + DFF));
      const f32x4 g0 = {bf_lo(gr.x), bf_hi(gr.x), bf_lo(gr.y), bf_hi(gr.y)}, v0 = {bf_lo(vr.x), bf_hi(vr.x), bf_lo(vr.y), bf_hi(vr.y)};
      const f32x4 cgv = bg + wg2 * g0 + wg1 * g1 + wg0 * g2;
      const f32x4 cvv = bv + wv2 * v0 + wv1 * v1 + wv0 * v2;
      f32x4 o;
#pragma unroll
      for (int e = 0; e < 4; ++e) o[e] = cgv[e] * sigmoidf_(cgv[e]) * cvv[e];
      st_bf4(ao + (size_t)t * DFF, o);
      g2 = g1; g1 = g0; v2 = v1; v1 = v0;
    }
  }
}

constexpr int NPL = 14, NPH = 1 + NL * NPL;
DEVI int phase_njobs(int pl, int l) {
  switch (pl) { case 1: return 1; case 3: return l > 0 ? 6 : 5; case 4: return l > 0 ? 1 : 0; case 6: return 1; case 8: return 1; case 9: return 1; case 11: return 1; case 13: return 1; default: return 0; }
}
DEVI GJob get_job(const Params& P, int pl, int l, int j) {
  unsigned char* ws = P.ws; GJob g{}; g.keep = 0;
  const float* mod = (const float*)(ws + WS_MOD) + l * 12288;
  switch (pl) {
    case 1: g.A = (const bf16_t*)(ws + A_H); g.lda = 2048; g.Bt = (const bf16_t*)(ws + WT_IN + (size_t)(l & 1) * WTIN_BYTES); g.ldb = 2048; g.N = PW; g.K = 2048; g.mode = 0; g.out = ws + A_P; g.ldo = PW; break;
    case 3:
      if (j == 0) { g.A = (const bf16_t*)(ws + A_QL); g.lda = 512; g.Bt = (const bf16_t*)(ws + WT_UQ); g.ldb = 512; g.N = 1536; g.K = 512; g.mode = 0; g.out = ws + A_QRAW; g.ldo = 1536; }
      else if (j == 1) { g.A = (const bf16_t*)(ws + A_CKV); g.lda = 512; g.Bt = (const bf16_t*)(ws + WT_UKV); g.ldb = 512; g.N = 2048; g.K = 512; g.mode = 0; g.out = ws + A_KVRAW; g.ldo = 2048; }
      else if (j == 2) { g.A = (const bf16_t*)(ws + A_AL); g.lda = 768; g.Bt = (const bf16_t*)(ws + WT_LW); g.ldb = 256; g.N = 1024; g.K = 256; g.mode = 1; g.out = ws + A_LW; g.ldo = 1024; }
      else if (j == 3) { g.A = (const bf16_t*)(ws + A_AL) + 256; g.lda = 768; g.Bt = (const bf16_t*)(ws + WT_LA); g.ldb = 256; g.N = 1024; g.K = 256; g.mode = 1; g.out = ws + A_LA; g.ldo = 1024; }
      else if (j == 4) { g.A = (const bf16_t*)(ws + A_AL) + 512; g.lda = 768; g.Bt = (const bf16_t*)(ws + WT_LG); g.ldb = 256; g.N = 1024; g.K = 256; g.mode = 0; g.out = ws + A_LG; g.ldo = 1024; }
      else { g.A = (const bf16_t*)(ws + A_VB); g.lda = 1024; g.Bt = (const bf16_t*)(ws + WT_V1); g.ldb = 1024; g.N = 256; g.K = 1024; g.mode = 0; g.out = ws + A_VL; g.ldo = 256; }
      break;
    case 4: g.A = (const bf16_t*)(ws + A_VL); g.lda = 256; g.Bt = (const bf16_t*)(ws + WT_V2); g.ldb = 256; g.N = 1024; g.K = 256; g.mode = 1; g.out = ws + A_VG; g.ldo = 1024; break;
    case 6: g.A = (const bf16_t*)(ws + A_H); g.lda = 2048; g.Bt = (const bf16_t*)(ws + WT_IN + (size_t)(l & 1) * WTIN_BYTES) + (size_t)PW * 2048; g.ldb = 2048; g.N = NGATE; g.K = 2048; g.mode = 2; g.out = ws + A_GATE; g.ldo = NGATE; break;
    case 8: g.A = (const bf16_t*)(ws + A_Y3); g.lda = 3072; g.Bt = (const bf16_t*)(ws + WT_BR); g.ldb = 3072; g.N = 2048; g.K = 3072; g.mode = 7;
            g.out = ws + A_MERG; g.aux = ws + A_GATE; g.ldo = 2048; break;
    case 9: g.A = (const bf16_t*)(ws + A_MERG); g.lda = 2048; g.Bt = (const bf16_t*)(ws + WT_OUT); g.ldb = 2048; g.N = 2048; g.K = 2048; g.mode = 6;
            g.out = ws + WS_X; g.aux = (l == 0) ? P.in[0] : (const void*)(ws + WS_X); g.aux2 = mod + 2 * 2048; g.ldo = 2048; break;
    case 11: g.A = (const bf16_t*)(ws + A_H); g.lda = 2048; g.Bt = (const bf16_t*)(ws + WT_UP); g.ldb = 2048; g.N = 11264; g.K = 2048; g.mode = 0; g.out = ws + A_UP; g.ldo = 11264; break;
    default: g.A = (const bf16_t*)(ws + A_ACT); g.lda = DFF; g.Bt = (const bf16_t*)(ws + WT_DN); g.ldb = DFF; g.N = 2048; g.K = DFF; g.mode = 6;
            g.out = (l == NL - 1) ? (void*)P.out : (void*)(ws + WS_X); g.aux = ws + WS_X; g.aux2 = mod + 5 * 2048; g.ldo = 2048; break;
  }
  g.A = (const bf16_t*)uptr(g.A); g.Bt = (const bf16_t*)uptr(g.Bt); g.out = (void*)uptr(g.out); g.aux = uptr(g.aux); g.aux2 = uptr(g.aux2);
  g.lda = __builtin_amdgcn_readfirstlane(g.lda); g.ldb = __builtin_amdgcn_readfirstlane(g.ldb); g.ldo = __builtin_amdgcn_readfirstlane(g.ldo);
  g.N = __builtin_amdgcn_readfirstlane(g.N); g.K = __builtin_amdgcn_readfirstlane(g.K); g.mode = __builtin_amdgcn_readfirstlane(g.mode); g.keep = __builtin_amdgcn_readfirstlane(g.keep);
  return g;
}

__global__ void __launch_bounds__(512) fwd_kernel(Params Parg) {
  extern __shared__ __attribute__((aligned(16))) unsigned char lds[];
  cg::grid_group grid = cg::this_grid();
  const int ph_lo = Parg.ph_lo, ph_hi = Parg.ph_hi;
  __shared__ uint4 xb_words;
  if (__builtin_amdgcn_workitem_id_x() == 0) xb_words = make_uint4(0u, 0u, 0u, 0u);
  __syncthreads();
  XcdBarrier xb = xcd_barrier_post((unsigned*)(Parg.ws + WS_BAR), (volatile LAS unsigned*)&xb_words);
  for (int ph = ph_lo; ph < ph_hi; ++ph) {
    const __attribute__((address_space(4))) Params* pp = (const __attribute__((address_space(4))) Params*)__builtin_amdgcn_kernarg_segment_ptr();
    asm volatile("" : "+s"(pp));
    const Params& P = *(const Params*)pp;
    unsigned char* ws = P.ws;
    int l = 0, pl = -1;
    if (ph > 0) { l = (ph - 1) / NPL; pl = (ph - 1) % NPL; }
    const float* mod = (const float*)(ws + WS_MOD) + l * 12288;
    const int nrep = ((ph > 0 && ((PROBE_MASK >> pl) & 1)) || (ph == 0 && ((PROBE_MASK >> 30) & 1))) ? 2 : 1;
    for (int rep = 0; rep < nrep; ++rep) {
    int c = lbid(), G = gridDim.x;
    if (ph == 0) { if (EN_INIT) phase_init(P, lds); }
    else switch (pl) {
      case 0: {
        const float* xin = (l == 0) ? (const float*)P.in[0] : (const float*)(ws + WS_X);
        if (EN_MISC) phase_h(xin, (const float*)P.in[5] + l * D, mod, mod + 2048, (bf16_t*)(ws + A_H));
      } break;
      case 2: if (EN_PREP) phase_prep1(P, l); break;
      case 5: if (EN_PREP) phase_prep2(P, l, lds); break;
      case 6: {
        if ((int)lbid() < NSCAN) { if (EN_SCAN && (rep == 0 || (PROBE_PART & 1))) scan_block(P, lbid(), lds); c = -1; }
        else {
          c = lbid() - NSCAN; G = gridDim.x - NSCAN;
          __syncthreads();
        }
      } break;
      case 7: if (EN_MISC) phase_post(P, l); break;
      case 10: if (EN_MISC) phase_h((const float*)(ws + WS_X), (const float*)P.in[6] + l * D, mod + 3 * 2048, mod + 4 * 2048, (bf16_t*)(ws + A_H)); break;
      case 12: if (EN_MISC) phase_conv(P, l); break;
      default: break;
    }
    {
      constexpr unsigned CM_IN = 0x1Fu, CM_SMALL = 0xFE0u, CM_LATE = 0x3F000u, CM_SG = 1u << 18;
      unsigned cm0 = 0, cm1 = 0; int cl1 = l + 1;
      int cc = c, cG = G;
      const int slot = (c & 7) * (G >> 3) + (c >> 3);
      if (ph == 0) cm0 = CM_IN | CM_SMALL | CM_SG;
      else if (pl == 1 && rep == 0) { cm0 = (1u << 15) | (1u << 16); cc = slot - 96; cG = 160; }
      else if (pl == 11 && l + 1 < NL && rep == 0) { cm1 = CM_IN | CM_SMALL | CM_SG; cc = slot - 128; cG = 128; }
      else if (pl == 6 && c >= 0 && (rep == 0 || (PROBE_PART & 16))) cm0 = (7u << 12) | (1u << 17);
      for (int k = 0; k < 2; ++k) { const unsigned m = k ? cm1 : cm0; if (m && EN_INIT && cc >= 0) convert_layer(P, k ? cl1 : l, m, cc, cG, lds); }
    }
    if (ph > 0) {
      const int nj = phase_njobs(pl, l);
      int cursor = 0;
      for (int j = 0; j < nj; ++j) { GJob jb = get_job(P, pl, l, j); if (EN_GEMM && (pl != 6 || rep == 0 || (PROBE_PART & 8))) gemm_job(jb, cursor, c, G, lds); }
    }
    if (ph > 0 && pl == 6 && c >= 0) {
      if (EN_ATTN && (rep == 0 || (PROBE_PART & 2))) {
        unsigned* qctr = (unsigned*)(ws + WS_BAR) + 3600 + (l * 2 + rep) * 64;
        volatile int* slot = (volatile int*)(lds + 131056);
        for (;;) {
          __syncthreads();
          if (ltid() == 0) *slot = (int)atomicAdd(qctr, 1u);
          __syncthreads();
          const int idx = *slot;
          if (idx >= 256) break;
          attn_block(P, idx & 7, 31 - (idx >> 3), lds);
        }
      }
      for (int it = c; it < 512; it += G) if (EN_SG && (rep == 0 || (PROBE_PART & 4))) sg_item(P, l, it >> 3, it & 7, lds);
      __syncthreads();
    }
    }
    if (ph_hi > 100000) grid.sync();
    if (ph + 1 < ph_hi && !(pl == 4 && l == 0)) xcd_barrier(xb);
  }
}

extern "C" void kernel_launch(void* const* d_in, const int* in_sizes, int n_in, void* d_out, int out_size, void* d_ws, size_t ws_size, hipStream_t stream) {
  static int grid = 0;
  if (grid == 0) {
    if (n_in != 42 || ws_size < WS_END) { fprintf(stderr, "kernel_launch: unexpected n_in %d / ws %zu (need %zu)\n", n_in, ws_size, (size_t)WS_END); grid = -1; return; }
    int dev = 0, cus = 0, per_cu = 0;
    hipGetDevice(&dev);
    hipDeviceGetAttribute(&cus, hipDeviceAttributeMultiprocessorCount, dev);
    if (hipFuncSetAttribute((const void*)fwd_kernel, hipFuncAttributeMaxDynamicSharedMemorySize, LDS_BYTES) != hipSuccess) { fprintf(stderr, "kernel_launch: hipFuncSetAttribute failed\n"); grid = -1; return; }
    hipOccupancyMaxActiveBlocksPerMultiprocessor(&per_cu, (const void*)fwd_kernel, 512, LDS_BYTES);
    if (per_cu < 1) { fprintf(stderr, "kernel_launch: occupancy query returned %d\n", per_cu); per_cu = 1; }
    (void)hipGetLastError();
    grid = cus;
  }
  if (grid < 0) return;
  Params p{};
  for (int i = 0; i < 42; ++i) p.in[i] = d_in[i];
  p.out = (float*)d_out; p.ws = (unsigned char*)d_ws;
  if (hipMemsetAsync((char*)d_ws + WS_MOD, 0, WS_BAR + 16384 - WS_MOD, stream) != hipSuccess)
#if N_LAUNCH_MODE == 1
  p.ph_lo = 0; p.ph_hi = NPH;
  void* args[] = {&p};
  hipError_t e = hipLaunchCooperativeKernel((const void*)fwd_kernel, dim3(grid), dim3(512), args, LDS_BYTES, stream);
  if (e != hipSuccess) fprintf(stderr, "cooperative launch failed: %s (grid %d)\n", hipGetErrorString(e), grid);
#else
  for (int ph = 0; ph < NPH; ++ph) {
    p.ph_lo = ph; p.ph_hi = ph + 1;
    hipLaunchKernelGGL(fwd_kernel, dim3(grid), dim3(512), LDS_BYTES, stream, p);
  }
#endif
}
```
